# Optimizing an MI355X kernel written in HIP

```python
import math
import jax, jax.numpy as jnp
from jax import lax
import numpy as np

D_MODEL = 1024
BATCH = 16
SEQ = 4096
DEPTH = 1
DEC_BATCH = 1
DEC_SEQ = 16384
PAST_LEN = 128

GRID_W = 64
D_MIX = D_MODEL
NA_HEAD_DIM = 64
NA_HEADS = (D_MIX // 2) // NA_HEAD_DIM
NA_WIDTH = NA_HEADS * NA_HEAD_DIM
NA_WIN_H = 8
NA_WIN_W = 16
NA_QBLK = 16
NA_KBLK = 32
RET_HEAD_DIM = 128
RET_HEADS = (D_MIX // 2) // RET_HEAD_DIM
RET_WIDTH = RET_HEADS * RET_HEAD_DIM
RET_CHUNK = 128
ROPE_BASE = 10000.0
NORM_EPS = 1e-6
IN_WIDTH = 4 * NA_WIDTH + 4 * RET_WIDTH

kernel_name = 'hybrid_na_retention_encoder'


def rms_norm(x, gain):
    xf = x.astype(jnp.float32)
    y = xf * lax.rsqrt(jnp.mean(xf * xf, axis=-1, keepdims=True) + NORM_EPS)
    return (y * gain.astype(jnp.float32)).astype(x.dtype)


def rotary(x):
    T, d = x.shape[2], x.shape[3]
    half = d // 2
    inv = ROPE_BASE ** (-jnp.arange(half, dtype=jnp.float32) / half)
    ang = jnp.arange(T, dtype=jnp.float32)[:, None] * inv[None, :]
    cos, sin = jnp.cos(ang), jnp.sin(ang)
    x1 = x[..., :half].astype(jnp.float32)
    x2 = x[..., half:].astype(jnp.float32)
    return jnp.concatenate([x1 * cos - x2 * sin, x1 * sin + x2 * cos], axis=-1).astype(x.dtype)


def _na_column_blocks():
    q_col = np.arange(GRID_W)
    win_start = np.clip(q_col - NA_WIN_W // 2, 0, GRID_W - NA_WIN_W)
    n_blk = GRID_W // NA_QBLK
    blk = np.arange(n_blk)
    k_start = np.clip(blk * NA_QBLK - NA_WIN_W // 2, 0, GRID_W - NA_KBLK)
    k_idx = k_start[:, None] + np.arange(NA_KBLK)
    q_idx = blk[:, None] * NA_QBLK + np.arange(NA_QBLK)
    ws = win_start[q_idx][:, :, None]
    kk = k_idx[:, None, :]
    valid = (kk >= ws) & (kk < ws + NA_WIN_W)
    dc = np.clip(kk - q_idx[:, :, None] + NA_WIN_W - 1, 0, 2 * NA_WIN_W - 2)
    return k_idx, valid, dc


def neighborhood_attention(q, k, v, rpb):
    B, H, T, d = q.shape
    rows = T // GRID_W
    kh = min(NA_WIN_H, rows)
    k_idx, valid, dc = _na_column_blocks()
    n_blk = k_idx.shape[0]
    kg = k.reshape(B, H, rows, GRID_W, d)
    vg = v.reshape(B, H, rows, GRID_W, d)
    qg = jnp.moveaxis(q.reshape(B, H, rows, GRID_W, d), 2, 0)
    bias_c = rpb.astype(jnp.float32)[:, :, dc]
    bias_c = jnp.where(valid, bias_c, -jnp.inf)

    def row_step(args):
        r, q_r = args
        start = jnp.clip(r - kh // 2, 0, rows - kh)
        k_rows = lax.dynamic_slice_in_dim(kg, start, kh, axis=2)
        v_rows = lax.dynamic_slice_in_dim(vg, start, kh, axis=2)
        k_blk = k_rows[:, :, :, k_idx]
        v_blk = v_rows[:, :, :, k_idx]
        q_b = q_r.reshape(B, H, n_blk, NA_QBLK, d)
        s = jnp.einsum('bhnqd,bhrnkd->bhnqrk', q_b, k_blk).astype(jnp.float32)
        dr = start + jnp.arange(kh) - r + (NA_WIN_H - 1)
        bias = jnp.transpose(bias_c[:, dr], (0, 2, 3, 1, 4))
        s = s + bias[None]
        p = jax.nn.softmax(s.reshape(B, H, n_blk, NA_QBLK, kh * NA_KBLK), axis=-1).reshape(s.shape)
        o = jnp.einsum('bhnqrk,bhrnkd->bhnqd', p.astype(v.dtype), v_blk)
        return o.reshape(B, H, GRID_W, d)

    out = lax.map(row_step, (jnp.arange(rows), qg))
    return jnp.moveaxis(out, 0, 2).reshape(B, H, T, d)


def retention_chunkwise(q, k, v, log_gamma, strict):
    B, H, T, dk = q.shape
    dv = v.shape[-1]
    C = RET_CHUNK
    N = T // C
    q = q.reshape(B, H, N, C, dk)
    k = k.reshape(B, H, N, C, dk)
    v = v.reshape(B, H, N, C, dv)
    pos = jnp.arange(C, dtype=jnp.float32)
    diff = pos[:, None] - pos[None, :]
    lower = (diff > 0) if strict else (diff >= 0)
    dmat = jnp.where(lower, jnp.exp(log_gamma[:, None, None] * jnp.maximum(diff, 0.0)), 0.0)
    s = jnp.einsum('bhnid,bhnjd->bhnij', q, k) * dmat[None, :, None]
    o_intra = jnp.einsum('bhnij,bhnjd->bhnid', s, v)
    k_dec = k * jnp.exp(log_gamma[:, None] * (C - 1 - pos)[None, :])[None, :, None, :, None]
    kv = jnp.einsum('bhnjd,bhnje->nbhde', k_dec, v).astype(jnp.float32)
    chunk_decay = jnp.exp(log_gamma * C)[None, :, None, None]

    def step(S, kv_n):
        return chunk_decay * S + kv_n, S

    _, S_prev = lax.scan(step, jnp.zeros((B, H, dk, dv), jnp.float32), kv)
    q_dec = q * jnp.exp(log_gamma[:, None] * (pos + 1.0)[None, :])[None, :, None, :, None]
    o_cross = jnp.einsum('bhnid,nbhde->bhnie', q_dec, S_prev)
    return (o_intra + o_cross).reshape(B, H, T, dv)


def encoder_layer(x, c, norm_gain, w_ada, b_ada, w_in, na_q_gain, na_k_gain, na_rpb,
                  ret_decay_f, ret_decay_b, ret_out_gain, w_out):
    B, T, _ = x.shape
    mod = jax.nn.silu(c) @ w_ada + b_ada
    shift, scale, gate = jnp.split(mod, 3, axis=-1)
    h = rms_norm(x, norm_gain) * (1 + scale[:, None]) + shift[:, None]
    proj = h @ w_in
    sizes = [NA_WIDTH] * 4 + [RET_WIDTH] * 4
    qa, ka, va, ga, qr, kr, vr, gr = jnp.split(proj, list(np.cumsum(sizes)[:-1]), axis=-1)

    def to_heads(t, n):
        return t.reshape(B, T, n, -1).transpose(0, 2, 1, 3)

    qa = rms_norm(to_heads(qa, NA_HEADS), na_q_gain) * (NA_HEAD_DIM ** -0.5)
    ka = rms_norm(to_heads(ka, NA_HEADS), na_k_gain)
    na = neighborhood_attention(qa, ka, to_heads(va, NA_HEADS), na_rpb)
    na = na.transpose(0, 2, 1, 3).reshape(B, T, NA_WIDTH) * jax.nn.silu(ga)

    qr = rotary(to_heads(qr, RET_HEADS))
    kr = rotary(to_heads(kr, RET_HEADS)) * (RET_HEAD_DIM ** -0.5)
    vr = to_heads(vr, RET_HEADS)
    lg_f = -jnp.exp(ret_decay_f.astype(jnp.float32))
    lg_b = -jnp.exp(ret_decay_b.astype(jnp.float32))
    flip = lambda t: t[:, :, ::-1]
    fwd = retention_chunkwise(qr, kr, vr, lg_f, strict=False)
    bwd = flip(retention_chunkwise(flip(qr), flip(kr), flip(vr), lg_b, strict=True))
    ret = (fwd + bwd).transpose(0, 2, 1, 3)
    ret = rms_norm(ret, ret_out_gain).reshape(B, T, RET_WIDTH).astype(x.dtype) * jax.nn.silu(gr)

    mix = jnp.concatenate([na, ret], axis=-1) @ w_out
    return x + gate[:, None] * mix


def setup_inputs(seed: int = 0) -> dict:
    key = jax.random.key(seed)
    ks = jax.random.split(key, 16)
    f32 = jnp.float32
    base = jnp.log(-jnp.log1p(-(2.0 ** (-5.0 - jnp.arange(RET_HEADS, dtype=f32)))))
    return {
        'x_prompt': jax.random.normal(ks[0], (BATCH, SEQ, D_MODEL), f32),
        'x_sample': jax.random.normal(ks[1], (DEC_BATCH, DEC_SEQ, D_MODEL), f32),
        'c_prompt': jax.random.normal(ks[2], (BATCH, D_MODEL), f32),
        'c_sample': jax.random.normal(ks[3], (DEC_BATCH, D_MODEL), f32),
        'norm_gain': 1.0 + 0.02 * jax.random.normal(ks[4], (DEPTH, D_MODEL), f32),
        'w_ada': 0.5 * D_MODEL ** -0.5 * jax.random.normal(ks[5], (DEPTH, D_MODEL, 3 * D_MODEL), f32),
        'b_ada': 0.02 * jax.random.normal(ks[6], (DEPTH, 3 * D_MODEL), f32),
        'w_in': D_MODEL ** -0.5 * jax.random.normal(ks[7], (DEPTH, D_MODEL, IN_WIDTH), f32),
        'na_q_gain': 1.0 + 0.02 * jax.random.normal(ks[8], (DEPTH, NA_HEAD_DIM), f32),
        'na_k_gain': 1.0 + 0.02 * jax.random.normal(ks[9], (DEPTH, NA_HEAD_DIM), f32),
        'na_rpb': 0.02 * jax.random.normal(ks[10], (DEPTH, NA_HEADS, 2 * NA_WIN_H - 1, 2 * NA_WIN_W - 1), f32),
        'ret_decay_f': base[None] + 0.01 * jax.random.normal(ks[11], (DEPTH, RET_HEADS), f32),
        'ret_decay_b': base[None] + 0.01 * jax.random.normal(ks[12], (DEPTH, RET_HEADS), f32),
        'ret_out_gain': 1.0 + 0.02 * jax.random.normal(ks[13], (DEPTH, RET_HEADS, RET_HEAD_DIM), f32),
        'w_out': D_MIX ** -0.5 * jax.random.normal(ks[14], (DEPTH, D_MIX, D_MODEL), f32),
    }


def reference(x_prompt, x_sample, c_prompt, c_sample, norm_gain, w_ada, b_ada, w_in,
              na_q_gain, na_k_gain, na_rpb, ret_decay_f, ret_decay_b, ret_out_gain, w_out):
    y_prompt = x_prompt
    y_sample = x_sample
    for l in range(DEPTH):
        y_prompt = encoder_layer(y_prompt, c_prompt, norm_gain[l], w_ada[l], b_ada[l], w_in[l],
                                 na_q_gain[l], na_k_gain[l], na_rpb[l], ret_decay_f[l],
                                 ret_decay_b[l], ret_out_gain[l], w_out[l])
        y_sample = encoder_layer(y_sample, c_sample, norm_gain[l], w_ada[l], b_ada[l], w_in[l],
                                 na_q_gain[l], na_k_gain[l], na_rpb[l], ret_decay_f[l],
                                 ret_decay_b[l], ret_out_gain[l], w_out[l])
    return (y_prompt, y_sample)
```

```cpp
#include <hip/hip_runtime.h>
#include <hip/hip_cooperative_groups.h>
#include <cstdio>
#include <cstdint>
namespace cg = cooperative_groups;
namespace pg8 {
#define PG8_LAS __attribute__((address_space(3)))
typedef unsigned short bf16_t;
typedef short bf16x8 __attribute__((ext_vector_type(8)));
typedef float f32x4 __attribute__((ext_vector_type(4)));
typedef unsigned u32x4 __attribute__((ext_vector_type(4)));
constexpr int BM = 256, BK = 64, HALF = 128, HTB = HALF * BK * 2  , STAGE_BYTES = 8 * HTB, NXCD = 8, WGM = 4;

__host__ __device__ __forceinline__ int lds_byte(int r, int c) { const int st = (r >> 4) * 2 + (c >> 5), rr = r & 15, cc = c & 31, ob = rr * 64 + cc * 2; return st * 1024 + (ob ^ (((ob >> 9) & 1) << 5)); }
__host__ __device__ __forceinline__ void stage_rc(int b, int& R, int& C) { const int st = b / 1024, sb = b % 1024, swz = sb ^ (((sb >> 9) & 1) << 5); R = (st >> 1) * 16 + swz / 64; C = (st & 1) * 32 + (swz % 64) / 2; }
__host__ __device__ __forceinline__ int perm32(int rho) { const int n = rho >> 4, i = rho & 15; return 8 * (i >> 2) + 4 * n + (i & 3); }

struct Unit { int pm, pn; };
struct Gemm { const bf16_t* A; const bf16_t* Bt; int M, N, K; };

struct StaticOrder {
    int nM, nN, nwg, G, c;
    __host__ __device__ void init(int M, int N, int G_, int c_) { nM = M / BM; nN = N / BM; nwg = nM * nN; G = G_; c = c_; }
    __host__ __device__ bool next(int i, Unit& u) const {
        const long L = (long)i * G + c; if (L >= nwg) return false;
        int wgid = (int)L; { const int q = nwg / NXCD, r = nwg % NXCD, xcd = wgid % NXCD, off = wgid / NXCD; wgid = (xcd < r ? xcd * (q + 1) : r * (q + 1) + (xcd - r) * q) + off; }
        const int nig = WGM * nN, gid = wgid / nig, fm = gid * WGM, gsz = (nM - fm) < WGM ? (nM - fm) : WGM;
        u.pm = fm + ((wgid % nig) % gsz); u.pn = (wgid % nig) / gsz; return true;
    }
    __device__ __forceinline__ void a_ready(const Unit&) const {}
    __device__ __forceinline__ void done(const Unit&) const {}
};

__device__ __forceinline__ unsigned cvt_pk_bf16(float lo, float hi) { unsigned r; asm volatile("v_cvt_pk_bf16_f32 %0, %1, %2" : "=v"(r) : "v"(lo), "v"(hi)); return r; }
template <class Epi, class Sched, bool ALIGN_EPI = false, bool SP2 = false>
__device__ __forceinline__ void gemm_phase(PG8_LAS unsigned char* lds, const Gemm g, const Sched& S, const Epi& E) {
    const int tid = threadIdx.x, wid = __builtin_amdgcn_readfirstlane(tid >> 6), lane = tid & 63, wr = wid >> 2, wc = wid & 3, fr = lane & 15, fq = lane >> 4;
    const int K = g.K, nt = K / BK;
    unsigned voffA[2], voffB[2];
#pragma unroll
    for (int i = 0; i < 2; ++i) { int R, C; stage_rc(tid * 16 + i * 8192, R, C); const int Rb = Epi::PERM ? ((R & ~31) + perm32(R & 31)) : R;
        voffA[i] = (unsigned)(R * K + C) * 2u; voffB[i] = (unsigned)(Rb * K + C) * 2u; }
    const size_t kstep = (size_t)(BK * 2);
    const size_t hstep = (size_t)HALF * K * 2;
    const size_t tstep = 2 * hstep;
    const unsigned ldsw = (unsigned)wid * 1024u;
    const int aoff = lds_byte(wr * 64 + fr, fq * 8), boff = lds_byte(wc * 32 + fr, fq * 8);
#define PG8_SA(b, h) (((b) * 2 + (h)) * HTB)
#define PG8_SB(b, h) ((4 + (b) * 2 + (h)) * HTB)
#define PG8_STAGE(bufoff, gbase, voff) do { _Pragma("unroll") for (int _i = 0; _i < 2; ++_i) \
        __builtin_amdgcn_global_load_lds((const unsigned*)((const char*)(gbase) + (voff)[_i]), (PG8_LAS unsigned*)(lds + (bufoff) + ldsw + _i * 8192), 16, 0, 0); } while (0)
#define PG8_LDA(dst, b, h) do { _Pragma("unroll") for (int m = 0; m < 4; ++m) _Pragma("unroll") for (int k = 0; k < 2; ++k) dst[m][k] = *(const PG8_LAS bf16x8*)(lds + PG8_SA(b, h) + aoff + m * 2048 + k * 1024); } while (0)
#define PG8_LDB(dst, b, h) do { _Pragma("unroll") for (int n = 0; n < 2; ++n) _Pragma("unroll") for (int k = 0; k < 2; ++k) dst[n][k] = *(const PG8_LAS bf16x8*)(lds + PG8_SB(b, h) + boff + n * 2048 + k * 1024); } while (0)
#define PG8_MMA(ai, bj, At, Bt) do { __builtin_amdgcn_s_setprio(1); _Pragma("unroll") for (int m = 0; m < 4; ++m) _Pragma("unroll") for (int n = 0; n < 2; ++n) _Pragma("unroll") for (int k = 0; k < 2; ++k) \
        acc[ai][bj][m][n] = __builtin_amdgcn_mfma_f32_16x16x32_bf16(Bt[n][k], At[m][k], acc[ai][bj][m][n], 0, 0, 0); __builtin_amdgcn_s_setprio(0); } while (0)
#define PG8_WAIT_V(n) asm volatile("s_waitcnt vmcnt(" #n ")" ::: "memory")
#define PG8_WAIT_L(n) asm volatile("s_waitcnt lgkmcnt(" #n ")" ::: "memory")
#define PG8_BAR __builtin_amdgcn_s_barrier()
#define PG8_SCHED __builtin_amdgcn_sched_barrier(0)
    Unit cur, nxt; int ui = 0;
    if (!S.next(0, cur)) return;
    f32x4 acc[2][2][4][2];
#pragma unroll
    for (int a = 0; a < 2; ++a)
#pragma unroll
        for (int b = 0; b < 2; ++b)
#pragma unroll
            for (int m = 0; m < 4; ++m)
#pragma unroll
                for (int n = 0; n < 2; ++n) acc[a][b][m][n] = (f32x4){0.f, 0.f, 0.f, 0.f};
    bf16x8 At[4][2], B0[2][2], B1[2][2];
    const char* cA = (const char*)g.A + (size_t)cur.pm * tstep; const char* cB = (const char*)g.Bt + (size_t)cur.pn * tstep;
    S.a_ready(cur);
    if constexpr (SP2) {
        PG8_STAGE(PG8_SB(0, 0), cB, voffB); PG8_STAGE(PG8_SB(0, 1), cB + hstep, voffB); PG8_STAGE(PG8_SA(0, 0), cA, voffA); PG8_STAGE(PG8_SA(0, 1), cA + hstep, voffA);
        if (wr == 1) PG8_BAR;
        PG8_WAIT_V(2); PG8_BAR;
        PG8_STAGE(PG8_SB(1, 0), cB + kstep, voffB); PG8_STAGE(PG8_SA(1, 0), cA + kstep, voffA); PG8_STAGE(PG8_SB(1, 1), cB + hstep + kstep, voffB);
        PG8_WAIT_V(6); PG8_BAR;
    } else {
        PG8_STAGE(PG8_SB(0, 0), cB, voffB); PG8_STAGE(PG8_SA(0, 0), cA, voffA); PG8_STAGE(PG8_SB(0, 1), cB + hstep, voffB); PG8_STAGE(PG8_SA(0, 1), cA + hstep, voffA);
        if (wr == 1) PG8_BAR;
        PG8_WAIT_V(4); PG8_BAR;
        PG8_STAGE(PG8_SB(1, 0), cB + kstep, voffB); PG8_STAGE(PG8_SA(1, 0), cA + kstep, voffA); PG8_STAGE(PG8_SB(1, 1), cB + hstep + kstep, voffB);
        PG8_WAIT_V(6); PG8_BAR;
    }
    for (;;) {
        const bool has_next = S.next(ui + 1, nxt);
        const char* nA = has_next ? (const char*)g.A + (size_t)nxt.pm * tstep : cA; const char* nB = has_next ? (const char*)g.Bt + (size_t)nxt.pn * tstep : cB;
        for (int t = 0; t < nt; t += 2) {
            const bool last = (t == nt - 2);
            const char* a1 = cA + (size_t)(t + 1) * kstep;
            const char* a2 = last ? nA : cA + (size_t)(t + 2) * kstep; const char* b2 = last ? nB : cB + (size_t)(t + 2) * kstep;
            const char* a3 = a2 + kstep; const char* b3 = b2 + kstep;
            if (last && has_next) S.a_ready(nxt);
            if constexpr (SP2) {
            PG8_LDB(B0, 0, 0); PG8_LDB(B1, 0, 1); PG8_SCHED; PG8_LDA(At, 0, 0); PG8_STAGE(PG8_SA(1, 1), a1 + hstep, voffA);
            PG8_WAIT_V(8); PG8_WAIT_L(0); PG8_BAR; PG8_MMA(0, 0, At, B0); PG8_MMA(0, 1, At, B1); PG8_BAR; PG8_SCHED;
            PG8_LDA(At, 0, 1); PG8_STAGE(PG8_SB(0, 0), b2, voffB); PG8_STAGE(PG8_SB(0, 1), b2 + hstep, voffB); PG8_STAGE(PG8_SA(0, 0), a2, voffA);
            PG8_WAIT_V(8); PG8_WAIT_L(0); PG8_BAR; PG8_MMA(1, 0, At, B0); PG8_MMA(1, 1, At, B1); PG8_BAR; PG8_SCHED;
            PG8_LDB(B0, 1, 0); PG8_LDB(B1, 1, 1); PG8_SCHED; PG8_LDA(At, 1, 0); PG8_STAGE(PG8_SA(0, 1), a2 + hstep, voffA);
            PG8_WAIT_V(8); PG8_WAIT_L(0); PG8_BAR; PG8_MMA(0, 0, At, B0); PG8_MMA(0, 1, At, B1); PG8_BAR; PG8_SCHED;
            PG8_LDA(At, 1, 1); PG8_STAGE(PG8_SB(1, 0), b3, voffB); PG8_STAGE(PG8_SB(1, 1), b3 + hstep, voffB); PG8_STAGE(PG8_SA(1, 0), a3, voffA);
            PG8_WAIT_V(8); PG8_WAIT_L(0); PG8_BAR; PG8_MMA(1, 0, At, B0); PG8_MMA(1, 1, At, B1); PG8_BAR; PG8_SCHED;
            } else {
            PG8_LDB(B0, 0, 0); PG8_SCHED; PG8_LDA(At, 0, 0); PG8_STAGE(PG8_SA(1, 1), a1 + hstep, voffA);
            PG8_WAIT_L(8); PG8_BAR; PG8_WAIT_L(0); PG8_MMA(0, 0, At, B0); PG8_BAR; PG8_SCHED;
            PG8_LDB(B1, 0, 1); PG8_STAGE(PG8_SB(0, 0), b2, voffB);
            PG8_BAR; PG8_WAIT_L(0); PG8_MMA(0, 1, At, B1); PG8_BAR;
            PG8_LDA(At, 0, 1); PG8_STAGE(PG8_SA(0, 0), a2, voffA);
            PG8_BAR; PG8_WAIT_L(0); PG8_MMA(1, 0, At, B0); PG8_BAR; PG8_SCHED;
            PG8_STAGE(PG8_SB(0, 1), b2 + hstep, voffB);
            PG8_WAIT_V(6); PG8_BAR; PG8_MMA(1, 1, At, B1); PG8_BAR;
            PG8_LDB(B0, 1, 0); PG8_SCHED; PG8_LDA(At, 1, 0); PG8_STAGE(PG8_SA(0, 1), a2 + hstep, voffA);
            PG8_WAIT_L(8); PG8_BAR; PG8_WAIT_L(0); PG8_MMA(0, 0, At, B0); PG8_BAR; PG8_SCHED;
            PG8_LDB(B1, 1, 1); PG8_STAGE(PG8_SB(1, 0), b3, voffB);
            PG8_BAR; PG8_WAIT_L(0); PG8_MMA(0, 1, At, B1); PG8_BAR;
            PG8_LDA(At, 1, 1); PG8_STAGE(PG8_SA(1, 0), a3, voffA);
            PG8_BAR; PG8_WAIT_L(0); PG8_MMA(1, 0, At, B0); PG8_BAR; PG8_SCHED;
            PG8_STAGE(PG8_SB(1, 1), b3 + hstep, voffB);
            PG8_WAIT_V(6); PG8_BAR; PG8_MMA(1, 1, At, B1); PG8_BAR;
            }
        }
        if constexpr (ALIGN_EPI) { if (wr == 0) PG8_BAR; }
        if constexpr (!Epi::AFTER_DRAIN) { E(acc, cur, wr, wc, fr, fq); S.done(cur); }
        if (!has_next) break;
#pragma unroll
        for (int a = 0; a < 2; ++a)
#pragma unroll
            for (int b = 0; b < 2; ++b)
#pragma unroll
                for (int m = 0; m < 4; ++m)
#pragma unroll
                    for (int n = 0; n < 2; ++n) acc[a][b][m][n] = (f32x4){0.f, 0.f, 0.f, 0.f};
        cur = nxt; cA = nA; cB = nB; ++ui;
        if constexpr (ALIGN_EPI) { if (wr == 1) PG8_BAR; }
    }
    PG8_WAIT_V(0);
    if constexpr (!ALIGN_EPI) { if (wr == 0) PG8_BAR; }
    PG8_BAR;
    if constexpr (Epi::AFTER_DRAIN) { E.fused(acc, cur, wr, wc, fr, fq, lds, wid, lane); S.done(cur); }
#undef PG8_SA
#undef PG8_SB
#undef PG8_STAGE
#undef PG8_LDA
#undef PG8_LDB
#undef PG8_MMA
#undef PG8_WAIT_V
#undef PG8_WAIT_L
#undef PG8_BAR
#undef PG8_SCHED
}
}

#define LAS __attribute__((address_space(3)))
using pg8::bf16_t; using pg8::bf16x8; using pg8::f32x4; using pg8::u32x4; using pg8::cvt_pk_bf16;
typedef short s16x4 __attribute__((ext_vector_type(4)));
typedef unsigned u32x2 __attribute__((ext_vector_type(2)));

constexpr int NTOK = 81920, NP = 65536, DM = 1024;
constexpr float LOG2E = 1.4426950408889634f;
constexpr float EPS = 1e-6f;
constexpr size_t MiB = (size_t)1 << 20;
constexpr size_t OFF_CTL = 0, OFF_MOD = 64 * 1024, OFF_ROPE = 1 * MiB, OFF_WTIN = 16 * MiB, OFF_WTOUT = 24 * MiB, OFF_H = 32 * MiB, OFF_MIX = 32 * MiB,
                 OFF_PROJ = 192 * MiB, OFF_ST = 832 * MiB, OFF_FIN = 992 * MiB, WS_NEED = 1000 * MiB;
constexpr size_t SEC_STRIDE = (size_t)NTOK * 512;
constexpr int LDS_BYTES = 152 * 1024, LDS_MISC = 150 * 1024;
constexpr int SCAN_UNITS = 320, RET_UNITS = 640 * 4;

struct Params {
    const float* xp; const float* xs; const float* cp; const float* csm;
    const float* norm_gain; const float* w_ada; const float* b_ada; const float* w_in;
    const float* qg; const float* kg; const float* rpb; const float* dec_f; const float* dec_b; const float* rgain; const float* w_out;
    float* out; unsigned char* ws;
};

__device__ __forceinline__ float bf_lo(unsigned u) { return __uint_as_float(u << 16); }
__device__ __forceinline__ float bf_hi(unsigned u) { return __uint_as_float(u & 0xffff0000u); }
__device__ __forceinline__ float silu_f(float x) { return x * __builtin_amdgcn_rcpf(1.f + __expf(-x)); }
__device__ __forceinline__ unsigned off256(unsigned row, unsigned ch) { return 256u * row + 16u * (ch ^ (((row & 3u) << 2) | ((row >> 2) & 3u))); }
__device__ __forceinline__ unsigned sw128(unsigned row) { return ((row >> 1) & 1u) | (((row >> 3) & 1u) << 1); }
__device__ __forceinline__ s16x4 tr_read(const LAS unsigned char* p) { return __builtin_amdgcn_ds_read_tr16_b64_v4i16((LAS s16x4*)p); }
__device__ __forceinline__ bf16x8 cat8(s16x4 a, s16x4 b) { return (bf16x8){a[0], a[1], a[2], a[3], b[0], b[1], b[2], b[3]}; }
__device__ __forceinline__ f32x4 mfma16(bf16x8 a, bf16x8 b, f32x4 c) { return __builtin_amdgcn_mfma_f32_16x16x32_bf16(a, b, c, 0, 0, 0); }
__device__ __forceinline__ float wave_sum(float v) {
#pragma unroll
    for (int o = 1; o < 64; o <<= 1) v += __shfl_xor(v, o);
    return v;
}
__device__ __forceinline__ float row4_sum(float v) {
    auto a = __builtin_amdgcn_permlane16_swap(__float_as_uint(v), __float_as_uint(v), false, false); v = __uint_as_float(a[0]) + __uint_as_float(a[1]);
    auto b = __builtin_amdgcn_permlane32_swap(__float_as_uint(v), __float_as_uint(v), false, false); return __uint_as_float(b[0]) + __uint_as_float(b[1]);
}
#define LDS_WAIT() asm volatile("s_waitcnt lgkmcnt(0)" ::: "memory")
#define LBAR() asm volatile("s_waitcnt lgkmcnt(0)\n\ts_barrier" ::: "memory")

__device__ __forceinline__ void transpose_item(const float* W, int K, int N, bf16_t* WT, int src_col0, int dst_row0, int k0, LAS float* scr, int lane) {
#pragma unroll 8
    for (int i = 0; i < 32; ++i) { const int kk = 2 * i + (lane >> 5); scr[kk * 33 + (lane & 31)] = W[(size_t)(k0 + kk) * N + src_col0 + (lane & 31)]; }
    LDS_WAIT();
    const int c = lane & 7;
#pragma unroll
    for (int j = 0; j < 4; ++j) { const int n = (lane >> 3) + 8 * j; const LAS float* s = scr + (8 * c) * 33 + n;
        u32x4 o; o.x = cvt_pk_bf16(s[0 * 33], s[1 * 33]); o.y = cvt_pk_bf16(s[2 * 33], s[3 * 33]); o.z = cvt_pk_bf16(s[4 * 33], s[5 * 33]); o.w = cvt_pk_bf16(s[6 * 33], s[7 * 33]);
        *(u32x4*)(WT + (size_t)(dst_row0 + n) * K + k0 + 8 * c) = o; }
    LDS_WAIT();
}

__device__ __forceinline__ void phase0a(const Params& P, LAS unsigned char* lds, int tid, int lane, int wave, int bid, int G) {
    float* mod = (float*)(P.ws + OFF_MOD);
    for (int it = bid; it < 96; it += G) {
        LAS float* sc = (LAS float*)lds;
        LAS float* red = (LAS float*)(lds + 72 * 1024);
        for (int i = tid; i < 17 * 1024; i += 512) { const float c = i < 16 * 1024 ? P.cp[i] : P.csm[i - 16 * 1024]; sc[i] = silu_f(c); }
        __syncthreads();
        const int cl = tid & 31, kg = tid >> 5, col = it * 32 + cl;
        float acc[17];
#pragma unroll
        for (int s = 0; s < 17; ++s) acc[s] = 0.f;
#pragma unroll 8
        for (int kk = 0; kk < 64; ++kk) { const int k = kg * 64 + kk; const float w = P.w_ada[(size_t)k * 3072 + col];
#pragma unroll
            for (int s = 0; s < 17; ++s) acc[s] += sc[s * 1024 + k] * w; }
#pragma unroll
        for (int s = 0; s < 17; ++s) red[(kg * 17 + s) * 32 + cl] = acc[s];
        __syncthreads();
        for (int i = tid; i < 17 * 32; i += 512) { const int s = i >> 5, c2 = i & 31; float v = P.b_ada[it * 32 + c2];
#pragma unroll
            for (int k2 = 0; k2 < 16; ++k2) v += red[(k2 * 17 + s) * 32 + c2];
            mod[s * 3072 + it * 32 + c2] = v; }
        __syncthreads();
    }
    LAS float* scr = (LAS float*)(lds + wave * 16384);
    const int nskip = G >= 192 ? 96 : 0;
    if (bid < nskip) return;
    const int gw = (bid - nskip) * 8 + wave, NGW = (G - nskip) * 8;
    bf16_t* WtIn = (bf16_t*)(P.ws + OFF_WTIN); bf16_t* WtOut = (bf16_t*)(P.ws + OFF_WTOUT);
    constexpr int I_IN = 16 * 128, I_OUT = 16 * 32;
    for (int it = gw; it < I_IN + I_OUT; it += NGW) {
        if (it < I_IN) {
            const int kb = it >> 7, n0 = (it & 127) * 32;
            const int pn = n0 >> 8, bj = (n0 >> 7) & 1, wc = (n0 >> 5) & 3, sec = pn >> 1, half = pn & 1;
            const int tc = (sec == 4 || sec == 5) ? 128 * (wc >> 1) + 64 * bj + 32 * (wc & 1) : 64 * wc + 32 * bj;
            transpose_item(P.w_in, 1024, 4096, WtIn, 512 * sec + 256 * half + tc, n0, kb * 64, scr, lane);
        } else {
            const int r = it - I_IN, kb = r >> 5, n0 = (r & 31) * 32;
            transpose_item(P.w_out, 1024, 1024, WtOut, n0, n0, kb * 64, scr, lane);
        }
    }
    float* ropec = (float*)(P.ws + OFF_ROPE); float* ropes = ropec + 16384 * 64;
    for (int t = gw; t < 16384; t += NGW) {
        double r = 0.8659643233600653, inv = 1.0;
#pragma unroll
        for (int b = 0; b < 6; ++b) { if ((lane >> b) & 1) inv *= r; r *= r; }
        const double ang = (double)t * inv, rev = ang * 0.15915494309189535, fr = rev - rint(rev), x = fr * 6.283185307179586, x2 = x * x;
        double sn = 1.0, cs = 1.0;
#pragma unroll
        for (int k = 14; k >= 1; --k) { sn = 1.0 - x2 * (1.0 / ((2.0 * k) * (2.0 * k + 1.0))) * sn; cs = 1.0 - x2 * (1.0 / ((2.0 * k - 1.0) * (2.0 * k))) * cs; }
        sn *= x;
        ropec[t * 64 + lane] = (float)cs; ropes[t * 64 + lane] = (float)sn;
    }
}

__device__ __forceinline__ void phase0b(const Params& P, int lane, int wave, int bid, int G) {
    const float* mod = (const float*)(P.ws + OFF_MOD); bf16_t* H = (bf16_t*)(P.ws + OFF_H);
    const int gw = bid * 8 + wave, NGW = G * 8;
    f32x4 v[2][4], vn[2][4];
#define P0B_LOAD(dst_, r0_) do { _Pragma("unroll") for (int rr = 0; rr < 2; ++rr) { const int row = min((r0_) + rr * NGW, NTOK - 1); \
            const float* xr = row < NP ? P.xp + (size_t)row * DM : P.xs + (size_t)(row - NP) * DM; \
            _Pragma("unroll") for (int j = 0; j < 4; ++j) dst_[rr][j] = *(const f32x4*)(xr + 8 * lane + 512 * (j >> 1) + 4 * (j & 1)); } } while (0)
    P0B_LOAD(v, gw);
    for (int row0 = gw; row0 < NTOK; row0 += 2 * NGW) {
        P0B_LOAD(vn, row0 + 2 * NGW);
        asm volatile("" ::: "memory");
        float ss[2];
#pragma unroll
        for (int rr = 0; rr < 2; ++rr) { float s2 = 0.f;
#pragma unroll
            for (int j = 0; j < 4; ++j) s2 += (v[rr][j].x * v[rr][j].x + v[rr][j].y * v[rr][j].y) + (v[rr][j].z * v[rr][j].z + v[rr][j].w * v[rr][j].w);
            ss[rr] = s2; }
#pragma unroll
        for (int rr = 0; rr < 2; ++rr) { const int row = row0 + rr * NGW; if (row >= NTOK) break;
            const int s = row < NP ? (row >> 12) : 16; const float* md = mod + s * 3072;
            const float rstd = rsqrtf(wave_sum(ss[rr]) * (1.f / DM) + EPS);
#pragma unroll
            for (int jj = 0; jj < 2; ++jj) { const int c = 8 * lane + 512 * jj; f32x4 hv[2];
#pragma unroll
                for (int e = 0; e < 2; ++e) { const f32x4 gn = *(const f32x4*)(P.norm_gain + c + 4 * e), sh = *(const f32x4*)(md + c + 4 * e), scv = *(const f32x4*)(md + 1024 + c + 4 * e);
                    hv[e] = (v[rr][2 * jj + e] * rstd * gn) * (scv + 1.f) + sh; }
                u32x4 o; o.x = cvt_pk_bf16(hv[0].x, hv[0].y); o.y = cvt_pk_bf16(hv[0].z, hv[0].w); o.z = cvt_pk_bf16(hv[1].x, hv[1].y); o.w = cvt_pk_bf16(hv[1].z, hv[1].w);
                *(u32x4*)(H + (size_t)row * DM + c) = o; } }
#pragma unroll
        for (int rr = 0; rr < 2; ++rr)
#pragma unroll
            for (int j = 0; j < 4; ++j) v[rr][j] = vn[rr][j];
    }
#undef P0B_LOAD
}

struct EpiIn {
    static constexpr bool PERM = true, AFTER_DRAIN = false;
    bf16_t* proj; const float* qg; const float* kg; const float* ropec; const float* ropes;
    __device__ __forceinline__ void operator()(const f32x4 (&acc)[2][2][4][2], const pg8::Unit& u, int wr, int wc, int fr, int fq) const {
        const int sec = u.pn >> 1, half = u.pn & 1;
        bf16_t* base = proj + (size_t)sec * SEC_STRIDE;
        const int row0 = u.pm * 256 + wr * 64 + fr;
        if (sec <= 1) {
            const float* gn = sec == 0 ? qg : kg; const float osc = sec == 0 ? 0.125f * LOG2E : 1.f;
            f32x4 g[2][2];
#pragma unroll
            for (int bj = 0; bj < 2; ++bj)
#pragma unroll
                for (int n = 0; n < 2; ++n) g[bj][n] = *(const f32x4*)(gn + 32 * bj + 8 * fq + 4 * n);
            const int col0 = 256 * half + 64 * wc + 8 * fq;
#pragma unroll
            for (int ai = 0; ai < 2; ++ai)
#pragma unroll
                for (int m = 0; m < 4; ++m) {
                    float ss = 0.f;
#pragma unroll
                    for (int bj = 0; bj < 2; ++bj)
#pragma unroll
                        for (int n = 0; n < 2; ++n) { const f32x4 x = acc[ai][bj][m][n]; ss += (x[0] * x[0] + x[1] * x[1]) + (x[2] * x[2] + x[3] * x[3]); }
                    ss = row4_sum(ss);
                    const float r = rsqrtf(ss * (1.f / 64.f) + EPS) * osc;
                    bf16_t* rowp = base + (size_t)(row0 + ai * 128 + m * 16) * 512 + col0;
#pragma unroll
                    for (int bj = 0; bj < 2; ++bj) { const f32x4 v0 = acc[ai][bj][m][0] * r * g[bj][0], v1 = acc[ai][bj][m][1] * r * g[bj][1];
                        u32x4 w; w.x = cvt_pk_bf16(v0[0], v0[1]); w.y = cvt_pk_bf16(v0[2], v0[3]); w.z = cvt_pk_bf16(v1[0], v1[1]); w.w = cvt_pk_bf16(v1[2], v1[3]);
                        *(u32x4*)(rowp + 32 * bj) = w; }
                }
        } else if (sec == 4 || sec == 5) {
            const float osc = sec == 5 ? 0.08838834764831845f : 1.f;
            const int col0 = 256 * half + 128 * (wc >> 1) + 32 * (wc & 1) + 8 * fq, i0 = 32 * (wc & 1) + 8 * fq;
            const int tb = row0 < NP ? (row0 & 4095) : row0 - NP;
            f32x4 c[2], sn[2], c16[2], s16[2];
#pragma unroll
            for (int e = 0; e < 2; ++e) { c[e] = *(const f32x4*)(ropec + tb * 64 + i0 + 4 * e); sn[e] = *(const f32x4*)(ropes + tb * 64 + i0 + 4 * e);
                c16[e] = *(const f32x4*)(ropec + 16 * 64 + i0 + 4 * e); s16[e] = *(const f32x4*)(ropes + 16 * 64 + i0 + 4 * e); }
            asm volatile("" ::: "memory");
#pragma unroll
            for (int k = 0; k < 12; ++k) {
                if (k < 4 || k >= 8) {
                    const int ai = k >> 3, m = k & 3;
                    const int row = row0 + ai * 128 + m * 16;
                    const f32x4 c0 = c[0] * osc, c1 = c[1] * osc, s0 = sn[0] * osc, s1 = sn[1] * osc;
                    const f32x4 a0 = acc[ai][0][m][0], a1 = acc[ai][0][m][1], b0 = acc[ai][1][m][0], b1 = acc[ai][1][m][1];
                    const f32x4 o10 = a0 * c0 - b0 * s0, o11 = a1 * c1 - b1 * s1, o20 = a0 * s0 + b0 * c0, o21 = a1 * s1 + b1 * c1;
                    bf16_t* rowp = base + (size_t)row * 512 + col0;
                    u32x4 w; w.x = cvt_pk_bf16(o10[0], o10[1]); w.y = cvt_pk_bf16(o10[2], o10[3]); w.z = cvt_pk_bf16(o11[0], o11[1]); w.w = cvt_pk_bf16(o11[2], o11[3]);
                    *(u32x4*)(rowp) = w;
                    w.x = cvt_pk_bf16(o20[0], o20[1]); w.y = cvt_pk_bf16(o20[2], o20[3]); w.z = cvt_pk_bf16(o21[0], o21[1]); w.w = cvt_pk_bf16(o21[2], o21[3]);
                    *(u32x4*)(rowp + 64) = w;
                }
                if (k < 11) {
#pragma unroll
                    for (int e = 0; e < 2; ++e) { const f32x4 cn = c[e] * c16[e] - sn[e] * s16[e]; sn[e] = sn[e] * c16[e] + c[e] * s16[e]; c[e] = cn; } }
            }
        } else {
            const bool act = (sec == 3 || sec == 7);
            const int col0 = 256 * half + 64 * wc + 8 * fq;
#pragma unroll
            for (int ai = 0; ai < 2; ++ai)
#pragma unroll
                for (int m = 0; m < 4; ++m) {
                    bf16_t* rowp = base + (size_t)(row0 + ai * 128 + m * 16) * 512 + col0;
#pragma unroll
                    for (int bj = 0; bj < 2; ++bj) { f32x4 v0 = acc[ai][bj][m][0], v1 = acc[ai][bj][m][1];
                        if (act) { v0 = (f32x4){silu_f(v0[0]), silu_f(v0[1]), silu_f(v0[2]), silu_f(v0[3])}; v1 = (f32x4){silu_f(v1[0]), silu_f(v1[1]), silu_f(v1[2]), silu_f(v1[3])}; }
                        u32x4 w; w.x = cvt_pk_bf16(v0[0], v0[1]); w.y = cvt_pk_bf16(v0[2], v0[3]); w.z = cvt_pk_bf16(v1[0], v1[1]); w.w = cvt_pk_bf16(v1[2], v1[3]);
                        *(u32x4*)(rowp + 32 * bj) = w; }
                }
        }
    }
};
struct EpiOut {
    static constexpr bool PERM = true, AFTER_DRAIN = false;
    const float* xp; const float* xs; const float* mod; float* out;
    __device__ __forceinline__ void operator()(const f32x4 (&acc)[2][2][4][2], const pg8::Unit& u, int wr, int wc, int fr, int fq) const {
        const int row0 = u.pm * 256 + wr * 64 + fr, col0 = u.pn * 256 + wc * 32 + 8 * fq;
        const int s = (u.pm * 256 < NP) ? ((u.pm * 256) >> 12) : 16;
        const float* gate = mod + s * 3072 + 2048;
        f32x4 gv[2][2];
#pragma unroll
        for (int bj = 0; bj < 2; ++bj)
#pragma unroll
            for (int n = 0; n < 2; ++n) gv[bj][n] = *(const f32x4*)(gate + col0 + 128 * bj + 4 * n);
        const float* xbase = (u.pm * 256 < NP) ? xp : xs - (size_t)NP * DM;
        f32x4 xv[2][2][2][2];
#define EO_LOAD(bt_) do { _Pragma("unroll") for (int mm = 0; mm < 2; ++mm) { const float* xr = xbase + (size_t)(row0 + ((bt_) >> 1) * 128 + (2 * ((bt_) & 1) + mm) * 16) * DM + col0; \
            _Pragma("unroll") for (int bj = 0; bj < 2; ++bj) _Pragma("unroll") for (int n = 0; n < 2; ++n) xv[(bt_) & 1][mm][bj][n] = *(const f32x4*)(xr + 128 * bj + 4 * n); } } while (0)
#define EO_STORE(bt_) do { _Pragma("unroll") for (int mm = 0; mm < 2; ++mm) { float* orow = out + (size_t)(row0 + ((bt_) >> 1) * 128 + (2 * ((bt_) & 1) + mm) * 16) * DM + col0; \
            _Pragma("unroll") for (int bj = 0; bj < 2; ++bj) _Pragma("unroll") for (int n = 0; n < 2; ++n) \
                *(f32x4*)(orow + 128 * bj + 4 * n) = xv[(bt_) & 1][mm][bj][n] + gv[bj][n] * acc[(bt_) >> 1][bj][2 * ((bt_) & 1) + mm][n]; } } while (0)
#define EO_FENCE() asm volatile("" ::: "memory")
        EO_LOAD(0); EO_FENCE(); EO_LOAD(1); EO_FENCE();
        EO_STORE(0); EO_FENCE(); EO_LOAD(2); EO_FENCE();
        EO_STORE(1); EO_FENCE(); EO_LOAD(3); EO_FENCE();
        EO_STORE(2); EO_FENCE(); EO_STORE(3);
#undef EO_LOAD
#undef EO_STORE
#undef EO_FENCE
    }
};

__device__ __forceinline__ void scan_unit(const Params& P, LAS unsigned char* lds, int vs, int h, int dir, int dvh, int tid, int lane, int wave) {
    const bf16_t* KR = (const bf16_t*)(P.ws + OFF_PROJ) + 5 * SEC_STRIDE; const bf16_t* VR = (const bf16_t*)(P.ws + OFF_PROJ) + 6 * SEC_STRIDE;
    bf16_t* ST = (bf16_t*)(P.ws + OFF_ST); bf16_t* FIN = (bf16_t*)(P.ws + OFF_FIN);
    const int cbase = vs * 32;
    const float lg2 = -__expf((dir ? P.dec_b : P.dec_f)[h]) * LOG2E;
    const float cd = exp2f(lg2 * 128.f);
    const int g = lane >> 4, l15 = lane & 15, q = l15 >> 2, p = lane & 3;
    const int dkt0 = 2 * (wave >> 1), dvt0 = 2 * (wave & 1);
    f32x4 acc[2][2];
#pragma unroll
    for (int a = 0; a < 2; ++a)
#pragma unroll
        for (int b = 0; b < 2; ++b) acc[a][b] = (f32x4){0.f, 0.f, 0.f, 0.f};
    u32x4 kA[4], vA[2], kB[4], vB[2];
#define SC_LOAD(KR_, VR_, c_) do { const size_t tok_ = (size_t)(cbase + (c_)) * 128; \
        _Pragma("unroll") for (int i_ = 0; i_ < 4; ++i_) { const int idx_ = tid + 512 * i_; KR_[i_] = *(const u32x4*)(KR + (tok_ + (idx_ >> 4)) * 512 + h * 128 + 8 * (idx_ & 15)); } \
        _Pragma("unroll") for (int i_ = 0; i_ < 2; ++i_) { const int idx_ = tid + 512 * i_; VR_[i_] = *(const u32x4*)(VR + (tok_ + (idx_ >> 3)) * 512 + h * 128 + 64 * dvh + 8 * (idx_ & 7)); } } while (0)
#define SC_STORE(KR_, VR_, buf_) do { LAS unsigned char* kb_ = lds + (buf_) * 49152; LAS unsigned char* vb_ = kb_ + 32768; \
        _Pragma("unroll") for (int i_ = 0; i_ < 4; ++i_) { const int idx_ = tid + 512 * i_; *(LAS u32x4*)(kb_ + off256(idx_ >> 4, idx_ & 15)) = KR_[i_]; } \
        _Pragma("unroll") for (int i_ = 0; i_ < 2; ++i_) { const int idx_ = tid + 512 * i_; const int row_ = idx_ >> 3, c16_ = idx_ & 7; \
            const float w_ = exp2f(lg2 * (float)(dir ? row_ : 127 - row_)); const u32x4 v_ = VR_[i_]; u32x4 o_; \
            o_.x = cvt_pk_bf16(bf_lo(v_.x) * w_, bf_hi(v_.x) * w_); o_.y = cvt_pk_bf16(bf_lo(v_.y) * w_, bf_hi(v_.y) * w_); \
            o_.z = cvt_pk_bf16(bf_lo(v_.z) * w_, bf_hi(v_.z) * w_); o_.w = cvt_pk_bf16(bf_lo(v_.w) * w_, bf_hi(v_.w) * w_); \
            *(LAS u32x4*)(vb_ + 128 * row_ + 16 * (c16_ ^ (2 * sw128(row_)))) = o_; } } while (0)
#define SC_WRITE(dst_) do { _Pragma("unroll") for (int a = 0; a < 2; ++a) _Pragma("unroll") for (int b = 0; b < 2; ++b) { const int dk0 = 16 * (dkt0 + a) + 4 * g, dv = 64 * dvh + 16 * (dvt0 + b) + l15; \
            u32x2 w; w.x = cvt_pk_bf16(acc[a][b][0], acc[a][b][1]); w.y = cvt_pk_bf16(acc[a][b][2], acc[a][b][3]); *(u32x2*)((dst_) + dv * 128 + dk0) = w; } } while (0)
#define CH(i_) (dir ? 31 - (i_) : (i_))
#define SC_STEP(step_, KN_, VN_) do { \
        bf16_t* st = ST + ((size_t)((cbase + CH(step_)) * 4 + h) * 2 + dir) * 16384; \
        SC_WRITE(st); \
        _Pragma("unroll") for (int a = 0; a < 2; ++a) _Pragma("unroll") for (int b = 0; b < 2; ++b) acc[a][b] = acc[a][b] * cd; \
        const LAS unsigned char* Kb = lds + ((step_) & 1) * 49152; const LAS unsigned char* Vb = Kb + 32768; \
        _Pragma("unroll") for (int ks = 0; ks < 4; ++ks) { \
            bf16x8 A[2], B[2]; const unsigned r0 = 32 * ks + 8 * g + q, r1 = r0 + 4; \
            _Pragma("unroll") for (int a = 0; a < 2; ++a) { const unsigned ch = 2 * (dkt0 + a) + (p >> 1); \
                A[a] = cat8(tr_read(Kb + off256(r0, ch) + 8 * (p & 1)), tr_read(Kb + off256(r1, ch) + 8 * (p & 1))); } \
            _Pragma("unroll") for (int b = 0; b < 2; ++b) { const unsigned blk = dvt0 + b; \
                B[b] = cat8(tr_read(Vb + 128 * r0 + 8 * (4 * (blk ^ sw128(r0)) + p)), tr_read(Vb + 128 * r1 + 8 * (4 * (blk ^ sw128(r1)) + p))); } \
            _Pragma("unroll") for (int a = 0; a < 2; ++a) _Pragma("unroll") for (int b = 0; b < 2; ++b) acc[a][b] = mfma16(A[a], B[b], acc[a][b]); } \
        if ((step_) + 1 < 32) SC_STORE(KN_, VN_, ((step_) + 1) & 1);            \
        if ((step_) + 3 < 32) SC_LOAD(KN_, VN_, CH((step_) + 3));               \
        LBAR(); } while (0)
    SC_LOAD(kA, vA, CH(0)); SC_LOAD(kB, vB, CH(1));
    SC_STORE(kA, vA, 0); LBAR();
    SC_LOAD(kA, vA, CH(2));
    for (int step = 0; step < 32; step += 2) {
        SC_STEP(step, kB, vB);
        SC_STEP(step + 1, kA, vA);
    }
    { bf16_t* fin = FIN + ((size_t)(vs * 4 + h) * 2 + dir) * 16384; SC_WRITE(fin); }
#undef SC_LOAD
#undef SC_STORE
#undef SC_WRITE
#undef SC_STEP
#undef CH
}

constexpr float NA_SHIFT = 14.f;
constexpr int NA_STRIPS = 640, NA_KR = 0, NA_VR = 9 * 8192, NA_RPB = 18 * 8192;
__device__ __forceinline__ int na_start(int r, int rows) { return min(max(r - 4, 0), rows - 8); }
__device__ __forceinline__ void na_strip(const Params& P, LAS unsigned char* lds, int strip, int hsel, int tid, int lane, int wave) {
    const bf16_t* PJ = (const bf16_t*)(P.ws + OFF_PROJ);
    const bf16_t* QA = PJ; const bf16_t* KA = PJ + SEC_STRIDE; const bf16_t* VA = PJ + 2 * SEC_STRIDE; const bf16_t* GA = PJ + 3 * SEC_STRIDE;
    bf16_t* MIX = (bf16_t*)(P.ws + OFF_MIX);
    int sq0, h, r0, rows;
    if (strip < 512) { sq0 = (strip >> 5) * 4096; h = (strip >> 2) & 7; r0 = (strip & 3) * 16; rows = 64; }
    else { const int v = strip - 512; sq0 = NP; h = v >> 4; r0 = (v & 15) * 16; rows = 256; }
    const int npairs = hsel < 0 ? 8 : 4; if (hsel > 0) r0 += 8;
    const int skey = tid >> 3, sc16 = tid & 7;
    const unsigned kdst = NA_KR + skey * 128 + 16 * (sc16 ^ (skey & 7)), vdst = NA_VR + skey * 128 + 16 * (sc16 ^ (((skey >> 1) & 3) << 1));
    const size_t ssrc = (size_t)skey * 512 + h * 64 + 8 * sc16;
    {
        const int lo = na_start(r0, rows);
        u32x4 kr[9], vr[9];
#pragma unroll
        for (int i = 0; i < 9; ++i) { const int row = min(lo + i, rows - 1); const size_t o = ((size_t)sq0 + (size_t)row * 64) * 512 + ssrc; kr[i] = *(const u32x4*)(KA + o); vr[i] = *(const u32x4*)(VA + o); }
#pragma unroll
        for (int i = 0; i < 9; ++i) { const int row = min(lo + i, rows - 1); const unsigned sl = (unsigned)(row % 9) * 8192u;
            if (lo + i < rows) { *(LAS u32x4*)(lds + sl + kdst) = kr[i]; *(LAS u32x4*)(lds + sl + vdst) = vr[i]; } }
        LAS float* rpbs = (LAS float*)(lds + NA_RPB);
        for (int i = tid; i < 465; i += 512) rpbs[i] = P.rpb[h * 465 + i] * LOG2E;
    }
    LBAR();
    const int rsel = wave >> 2, nb = wave & 3;
    const int g = lane >> 4, l15 = lane & 15, q4 = l15 >> 2, p = lane & 3;
    const int kstart = nb == 0 ? 0 : (nb == 1 ? 8 : (nb == 2 ? 24 : 32));
    const int qc = 16 * nb + l15, wsq = min(max(qc - 8, 0), 48);
    const LAS float* rp = (const LAS float*)(lds + NA_RPB);
    float msk[2][4]; int bofs[2][4];
#pragma unroll
    for (int kt = 0; kt < 2; ++kt)
#pragma unroll
        for (int i = 0; i < 4; ++i) { const int kc = kstart + 16 * kt + 4 * g + i; msk[kt][i] = ((kc >= wsq) && (kc < wsq + 16)) ? -NA_SHIFT : -INFINITY; bofs[kt][i] = min(max(kc - qc + 15, 0), 30); }
    bf16x8 qf[2];
    {   const size_t tq = (size_t)sq0 + (size_t)(r0 + rsel) * 64 + qc;
#pragma unroll
        for (int ks = 0; ks < 2; ++ks) qf[ks] = *(const bf16x8*)(QA + tq * 512 + h * 64 + 32 * ks + 8 * g); }
    for (int pi = 0; pi < npairs; ++pi) {
        const int r = r0 + 2 * pi, myr = r + rsel;
        const size_t tq = (size_t)sq0 + (size_t)myr * 64 + qc;
        const int lo = na_start(r, rows), lon = na_start(r + 2, rows);
        const int nr0 = lo + 9, nr1 = lo + 10;
        const bool need0 = (pi < npairs - 1) && (nr0 < lon + 9) && (nr0 < rows), need1 = (pi < npairs - 1) && (nr1 < lon + 9) && (nr1 < rows);
        u32x4 nk0, nv0, nk1, nv1;
        if (need0) { const size_t o = ((size_t)sq0 + (size_t)nr0 * 64) * 512 + ssrc; nk0 = *(const u32x4*)(KA + o); nv0 = *(const u32x4*)(VA + o); }
        if (need1) { const size_t o = ((size_t)sq0 + (size_t)nr1 * 64) * 512 + ssrc; nk1 = *(const u32x4*)(KA + o); nv1 = *(const u32x4*)(VA + o); }
        bf16x8 qn[2];
        if (pi < npairs - 1) {
#pragma unroll
            for (int ks = 0; ks < 2; ++ks) qn[ks] = *(const bf16x8*)(QA + (tq + 128) * 512 + h * 64 + 32 * ks + 8 * g); }
        u32x2 gv[4];
#pragma unroll
        for (int dt = 0; dt < 4; ++dt) gv[dt] = *(const u32x2*)(GA + tq * 512 + h * 64 + 16 * dt + 4 * g);
        const int start = na_start(myr, rows);
        f32x4 sc[8][2];
#pragma unroll
        for (int j = 0; j < 8; ++j) { const LAS float* rpj = rp + (start + j - myr + 7) * 31;
#pragma unroll
            for (int kt = 0; kt < 2; ++kt)
#pragma unroll
                for (int i = 0; i < 4; ++i) sc[j][kt][i] = rpj[bofs[kt][i]] + msk[kt][i]; }
#pragma unroll
        for (int j = 0; j < 8; ++j) { const LAS unsigned char* kt_ = lds + NA_KR + (unsigned)((start + j) % 9) * 8192u;
#pragma unroll
            for (int kt = 0; kt < 2; ++kt) { const unsigned key = kstart + 16 * kt + l15; const LAS unsigned char* kp = kt_ + key * 128;
                f32x4 a = sc[j][kt];
                a = mfma16(*(const LAS bf16x8*)(kp + 16 * ((unsigned)g ^ (key & 7))), qf[0], a);
                a = mfma16(*(const LAS bf16x8*)(kp + 16 * ((unsigned)(4 + g) ^ (key & 7))), qf[1], a);
                sc[j][kt] = a; } }
#pragma unroll
        for (int j = 0; j < 8; ++j)
#pragma unroll
            for (int kt = 0; kt < 2; ++kt)
#pragma unroll
                for (int i = 0; i < 4; ++i) sc[j][kt][i] = __builtin_amdgcn_exp2f(sc[j][kt][i]);
        f32x4 o[4], osum = (f32x4){0.f, 0.f, 0.f, 0.f};
#pragma unroll
        for (int dt = 0; dt < 4; ++dt) o[dt] = (f32x4){0.f, 0.f, 0.f, 0.f};
        const bf16x8 ones8 = (bf16x8){0x3f80, 0x3f80, 0x3f80, 0x3f80, 0x3f80, 0x3f80, 0x3f80, 0x3f80};
#pragma unroll
        for (int j = 0; j < 8; ++j) {
            u32x4 pw; pw.x = cvt_pk_bf16(sc[j][0][0], sc[j][0][1]); pw.y = cvt_pk_bf16(sc[j][0][2], sc[j][0][3]); pw.z = cvt_pk_bf16(sc[j][1][0], sc[j][1][1]); pw.w = cvt_pk_bf16(sc[j][1][2], sc[j][1][3]);
            const bf16x8 pb = __builtin_bit_cast(bf16x8, pw);
            const LAS unsigned char* vt = lds + NA_VR + (unsigned)((start + j) % 9) * 8192u;
            const unsigned k0 = kstart + 4 * g + q4, k1 = k0 + 16;
            const unsigned x0 = 4 * ((k0 >> 1) & 3), x1 = 4 * ((k1 >> 1) & 3);
#pragma unroll
            for (int dt = 0; dt < 4; ++dt) {
                const bf16x8 va = cat8(tr_read(vt + k0 * 128 + 8 * ((unsigned)(4 * dt + p) ^ x0)), tr_read(vt + k1 * 128 + 8 * ((unsigned)(4 * dt + p) ^ x1)));
                o[dt] = mfma16(va, pb, o[dt]); }
            osum = mfma16(ones8, pb, osum);
        }
        const float inv = __builtin_amdgcn_rcpf(osum[0]);
#pragma unroll
        for (int dt = 0; dt < 4; ++dt) {
            u32x2 w; w.x = cvt_pk_bf16(o[dt][0] * inv * bf_lo(gv[dt].x), o[dt][1] * inv * bf_hi(gv[dt].x)); w.y = cvt_pk_bf16(o[dt][2] * inv * bf_lo(gv[dt].y), o[dt][3] * inv * bf_hi(gv[dt].y));
            *(u32x2*)(MIX + tq * DM + h * 64 + 16 * dt + 4 * g) = w; }
        LBAR();
        if (need0) { const unsigned sl = (unsigned)(nr0 % 9) * 8192u; *(LAS u32x4*)(lds + sl + kdst) = nk0; *(LAS u32x4*)(lds + sl + vdst) = nv0; }
        if (need1) { const unsigned sl = (unsigned)(nr1 % 9) * 8192u; *(LAS u32x4*)(lds + sl + kdst) = nk1; *(LAS u32x4*)(lds + sl + vdst) = nv1; }
        if (pi < npairs - 1) { qf[0] = qn[0]; qf[1] = qn[1]; }
        LBAR();
    }
}

__device__ __forceinline__ void ret_phase(const Params& P, LAS unsigned char* lds, int tid, int lane, int wave, int bid, int G) {
    const bf16_t* PJ = (const bf16_t*)(P.ws + OFF_PROJ);
    const bf16_t* QR = PJ + 4 * SEC_STRIDE; const bf16_t* KR = PJ + 5 * SEC_STRIDE; const bf16_t* VR = PJ + 6 * SEC_STRIDE; const bf16_t* GR = PJ + 7 * SEC_STRIDE;
    const bf16_t* ST = (const bf16_t*)(P.ws + OFF_ST); const bf16_t* FIN = (const bf16_t*)(P.ws + OFF_FIN); bf16_t* MIX = (bf16_t*)(P.ws + OFF_MIX);
    LAS unsigned char* Qt = lds; LAS unsigned char* Kt = lds + 32768; LAS unsigned char* Vt = lds + 65536; LAS unsigned char* Pt = lds + 98304;
    int g = lane >> 4, l15 = lane & 15, q4 = l15 >> 2, p = lane & 3, w16 = wave * 16;
#define OPQ_ALL() do { asm volatile("" : "+v"(g), "+v"(l15), "+v"(q4), "+v"(p)); } while (0)
    int u = bid; if (u >= RET_UNITS) return;
    u32x4 rq[4], rk[4], rv[4];
#define RT_LOAD(u_) do { const size_t tokc_ = (size_t)((u_) >> 2) * 128; const int h_ = (u_) & 3; \
        _Pragma("unroll") for (int i = 0; i < 4; ++i) { const int idx = tid + 512 * i; const size_t src = (tokc_ + (idx >> 4)) * 512 + h_ * 128 + 8 * (idx & 15); \
            rq[i] = *(const u32x4*)(QR + src); rk[i] = *(const u32x4*)(KR + src); rv[i] = *(const u32x4*)(VR + src); } } while (0)
    RT_LOAD(u);
    for (; u < RET_UNITS; u += G) {
        const int gc = u >> 2, h = u & 3; const size_t tokc = (size_t)gc * 128;
        const float lgf2 = -__expf(P.dec_f[h]) * LOG2E, lgb2 = -__expf(P.dec_b[h]) * LOG2E;
#pragma unroll
        for (int i = 0; i < 4; ++i) { const int idx = tid + 512 * i; const unsigned d = off256(idx >> 4, idx & 15);
            *(LAS u32x4*)(Qt + d) = rq[i]; *(LAS u32x4*)(Kt + d) = rk[i]; *(LAS u32x4*)(Vt + d) = rv[i]; }
        LBAR();
        const bf16_t* Sf = ST + ((size_t)(gc * 4 + h) * 2 + 0) * 16384; const bf16_t* Sb = Sf + 16384;
        u32x4 sfr[4], sbr[4];
#pragma unroll
        for (int i = 0; i < 4; ++i) { const int idx = tid + 512 * i; sfr[i] = *(const u32x4*)(Sf + 8 * idx); sbr[i] = *(const u32x4*)(Sb + 8 * idx); }
        OPQ_ALL();
        bf16x8 qf[4];
#pragma unroll
        for (int ks = 0; ks < 4; ++ks) qf[ks] = *(const LAS bf16x8*)(Qt + off256(w16 + l15, 4 * ks + g));
        {
            const int n = w16 + l15;
            f32x4 sa[8];
#pragma unroll
            for (int mt = 0; mt < 8; ++mt) {
                f32x4 a = (f32x4){0.f, 0.f, 0.f, 0.f};
#pragma unroll
                for (int ks = 0; ks < 4; ++ks) a = mfma16(*(const LAS bf16x8*)(Kt + off256(16 * mt + l15, 4 * ks + g)), qf[ks], a);
                sa[mt] = a; }
#pragma unroll
            for (int mt = 0; mt < 8; ++mt) {
                const f32x4 a = sa[mt];
                float e[4];
#pragma unroll
                for (int i = 0; i < 4; ++i) { const int m = 16 * mt + 4 * g + i, df = n - m; const float f = __builtin_amdgcn_exp2f(df >= 0 ? lgf2 * (float)df : lgb2 * (float)(-df)); e[i] = a[i] * f; }
                u32x2 w; w.x = cvt_pk_bf16(e[0], e[1]); w.y = cvt_pk_bf16(e[2], e[3]);
                *(LAS u32x2*)(Pt + off256(n, 2 * mt + (g >> 1)) + 8 * (g & 1)) = w;
            }
        }
        LBAR();
        if (gc >= 512) {
            const int k = (gc - 512) >> 5, j = gc & 31;
            const float cf = exp2f(lgf2 * 128.f * (float)j), cb = exp2f(lgb2 * 128.f * (float)(31 - j)), df32 = exp2f(lgf2 * 4096.f), db32 = exp2f(lgb2 * 4096.f);
            float wgt = cf;
            for (int i2 = k - 1; i2 >= 0; --i2) { const bf16_t* F = FIN + ((size_t)((16 + i2) * 4 + h) * 2 + 0) * 16384;
#pragma unroll
                for (int i = 0; i < 4; ++i) { const u32x4 f = *(const u32x4*)(F + 8 * (tid + 512 * i)); u32x4 s = sfr[i];
                    s.x = cvt_pk_bf16(bf_lo(s.x) + wgt * bf_lo(f.x), bf_hi(s.x) + wgt * bf_hi(f.x)); s.y = cvt_pk_bf16(bf_lo(s.y) + wgt * bf_lo(f.y), bf_hi(s.y) + wgt * bf_hi(f.y));
                    s.z = cvt_pk_bf16(bf_lo(s.z) + wgt * bf_lo(f.z), bf_hi(s.z) + wgt * bf_hi(f.z)); s.w = cvt_pk_bf16(bf_lo(s.w) + wgt * bf_lo(f.w), bf_hi(s.w) + wgt * bf_hi(f.w)); sfr[i] = s; }
                wgt *= df32; }
            wgt = cb;
            for (int i2 = k + 1; i2 < 4; ++i2) { const bf16_t* F = FIN + ((size_t)((16 + i2) * 4 + h) * 2 + 1) * 16384;
#pragma unroll
                for (int i = 0; i < 4; ++i) { const u32x4 f = *(const u32x4*)(F + 8 * (tid + 512 * i)); u32x4 s = sbr[i];
                    s.x = cvt_pk_bf16(bf_lo(s.x) + wgt * bf_lo(f.x), bf_hi(s.x) + wgt * bf_hi(f.x)); s.y = cvt_pk_bf16(bf_lo(s.y) + wgt * bf_lo(f.y), bf_hi(s.y) + wgt * bf_hi(f.y));
                    s.z = cvt_pk_bf16(bf_lo(s.z) + wgt * bf_lo(f.z), bf_hi(s.z) + wgt * bf_hi(f.z)); s.w = cvt_pk_bf16(bf_lo(s.w) + wgt * bf_lo(f.w), bf_hi(s.w) + wgt * bf_hi(f.w)); sbr[i] = s; }
                wgt *= db32; }
        }
#pragma unroll
        for (int i = 0; i < 4; ++i) { const int idx = tid + 512 * i; const unsigned d = off256(idx >> 4, idx & 15); *(LAS u32x4*)(Qt + d) = sfr[i]; *(LAS u32x4*)(Kt + d) = sbr[i]; }
        if (u + G < RET_UNITS) RT_LOAD(u + G);
        LBAR();
        OPQ_ALL();
        f32x4 o[8];
#pragma unroll
        for (int t = 0; t < 8; ++t) o[t] = (f32x4){0.f, 0.f, 0.f, 0.f};
        u32x4 grv[4];
#pragma unroll
        for (int it = 0; it < 4; ++it) grv[it] = *(const u32x4*)(GR + (tokc + w16 + 4 * it + g) * 512 + h * 128 + 8 * l15);
#pragma unroll
        for (int t = 0; t < 8; ++t)
#pragma unroll
            for (int ks = 0; ks < 4; ++ks) { o[t] = mfma16(qf[ks], *(const LAS bf16x8*)(Qt + off256(16 * t + l15, 4 * ks + g)), o[t]); }
        float wb[4];
#pragma unroll
        for (int i = 0; i < 4; ++i) { const float pos = (float)(w16 + 4 * g + i); const float wf = exp2f(lgf2 * (pos + 1.f)); wb[i] = exp2f(lgb2 * (128.f - pos)); const float rt = wf / wb[i];
#pragma unroll
            for (int t = 0; t < 8; ++t) o[t][i] *= rt; }
#pragma unroll
        for (int t = 0; t < 8; ++t)
#pragma unroll
            for (int ks = 0; ks < 4; ++ks) { o[t] = mfma16(qf[ks], *(const LAS bf16x8*)(Kt + off256(16 * t + l15, 4 * ks + g)), o[t]); }
#pragma unroll
        for (int i = 0; i < 4; ++i)
#pragma unroll
            for (int t = 0; t < 8; ++t) o[t][i] *= wb[i];
        OPQ_ALL();
#pragma unroll
        for (int ks = 0; ks < 4; ++ks) {
            const bf16x8 pa = *(const LAS bf16x8*)(Pt + off256(w16 + l15, 4 * ks + g));
            const unsigned r0 = 32 * ks + 8 * g + q4, r1 = r0 + 4;
#pragma unroll
            for (int t = 0; t < 8; ++t) { const unsigned ch = 2 * t + (p >> 1);
                const bf16x8 vb = cat8(tr_read(Vt + off256(r0, ch) + 8 * (p & 1)), tr_read(Vt + off256(r1, ch) + 8 * (p & 1)));
                o[t] = mfma16(pa, vb, o[t]); }
        }
        OPQ_ALL();
        float rs[4];
#pragma unroll
        for (int i = 0; i < 4; ++i) { float ss = 0.f;
#pragma unroll
            for (int t = 0; t < 8; ++t) ss += o[t][i] * o[t][i];
            ss += __shfl_xor(ss, 1); ss += __shfl_xor(ss, 2); ss += __shfl_xor(ss, 4); ss += __shfl_xor(ss, 8);
            rs[i] = rsqrtf(ss * (1.f / 128.f) + EPS); }
        LBAR();
#pragma unroll
        for (int t = 0; t < 8; ++t) { const int dv = 16 * t + l15; const float gn = P.rgain[h * 128 + dv];
#pragma unroll
            for (int i = 0; i < 4; ++i) { const int n = w16 + 4 * g + i; const unsigned wv = cvt_pk_bf16(o[t][i] * rs[i] * gn, 0.f);
                *(LAS unsigned short*)(Pt + off256(n, dv >> 3) + 2 * (dv & 7)) = (unsigned short)(wv & 0xffffu); } }
        LBAR();
#pragma unroll
        for (int it = 0; it < 4; ++it) { const int row = w16 + 4 * it + g, ch = l15;
            const u32x4 ov = *(const LAS u32x4*)(Pt + off256(row, ch));
            const u32x4 gv = grv[it];
            u32x4 w; w.x = cvt_pk_bf16(bf_lo(ov.x) * bf_lo(gv.x), bf_hi(ov.x) * bf_hi(gv.x)); w.y = cvt_pk_bf16(bf_lo(ov.y) * bf_lo(gv.y), bf_hi(ov.y) * bf_hi(gv.y));
            w.z = cvt_pk_bf16(bf_lo(ov.z) * bf_lo(gv.z), bf_hi(ov.z) * bf_hi(gv.z)); w.w = cvt_pk_bf16(bf_lo(ov.w) * bf_lo(gv.w), bf_hi(ov.w) * bf_hi(gv.w));
            *(u32x4*)(MIX + (tokc + row) * DM + 512 + h * 128 + 8 * ch) = w; }
        LBAR();
    }
#undef RT_LOAD
#undef OPQ_ALL
}

#define XB_TMO      128
#define XB_XCNT(j)  (256  + 64 * (j))
#define XB_XSUB(j)  (1280 + 64 * (j))
#define XB_XGEN(j)  (2304 + 64 * (j))
#define XB_TOP      3328
#define XB_TOPGEN   3392
#define XCD_BAR_WORDS 3456
#define XB_SPIN_CAP (1u << 18)

__device__ __forceinline__ unsigned xb_ld(unsigned* p)              { return __hip_atomic_load(p, __ATOMIC_RELAXED, __HIP_MEMORY_SCOPE_AGENT); }
__device__ __forceinline__ unsigned xb_add(unsigned* p, unsigned v) { return __hip_atomic_fetch_add(p, v, __ATOMIC_RELAXED, __HIP_MEMORY_SCOPE_AGENT); }
__device__ __forceinline__ unsigned xb_xcc_id() { return (unsigned)__builtin_amdgcn_s_getreg((3 << 11) | 20) & 0xFu; }
#define XB_SPIN(cond, bar) do { unsigned _sp = 0; while (cond) { __builtin_amdgcn_s_sleep(1); \
    if ((++_sp & 255u) == 0u) { if (xb_ld(&(bar)[XB_TMO])) break; if (_sp > XB_SPIN_CAP) { atomicAdd(&(bar)[XB_TMO], 1u); break; } } } } while (0)

struct XcdBarrier {
    unsigned* bar; unsigned x;
    volatile LAS unsigned* st;
};

__device__ __forceinline__ XcdBarrier xcd_barrier_post(unsigned* bar, volatile LAS unsigned* st) {
    XcdBarrier b; b.bar = bar; b.x = xb_xcc_id(); b.st = st;
    if (threadIdx.x == 0) (void)xb_add(&bar[XB_XCNT(b.x)], 1u);
    return b;
}
__device__ __forceinline__ void xcd_barrier_complete(unsigned* bar, unsigned x, unsigned& nloc, unsigned& nx) {
    const unsigned G = gridDim.x * gridDim.y * gridDim.z;
    unsigned sum, cnt, mine, sp = 0u;
    for (;;) {
        sum = 0u; cnt = 0u; mine = 0u;
#pragma unroll
        for (unsigned j = 0; j < 16; ++j) { const unsigned c = xb_ld(&bar[XB_XCNT(j)]); sum += c; cnt += (c > 0u) ? 1u : 0u; mine = (j == x) ? c : mine; }
        if (sum == G) break;
        __builtin_amdgcn_s_sleep(1);
        if ((++sp & 255u) == 0u) { if (xb_ld(&bar[XB_TMO])) break; if (sp > XB_SPIN_CAP) { atomicAdd(&bar[XB_TMO], 1u); break; } }
    }
    nloc = mine > 0u ? mine : 1u; nx = cnt > 0u ? cnt : 1u;
}

__device__ __forceinline__ void xcd_barrier(const XcdBarrier& b) {
    asm volatile("s_waitcnt vmcnt(0)" ::: "memory");
    __syncthreads();
    if (threadIdx.x == 0) {
        unsigned* bar = b.bar;
        __builtin_amdgcn_s_waitcnt(0);
        unsigned nloc = b.st[0], nx = b.st[1];
        if (nloc == 0u) { xcd_barrier_complete(bar, b.x, nloc, nx); b.st[0] = nloc; b.st[1] = nx; }
        const unsigned old = xb_add(&bar[XB_XSUB(b.x)], 1u);
        const unsigned gen = old / nloc;
        if (old + 1u == (gen + 1u) * nloc) {
            __builtin_amdgcn_fence(__ATOMIC_RELEASE, "agent");
            asm volatile("s_waitcnt vmcnt(0)" ::: "memory");
            const unsigned og = xb_add(&bar[XB_TOP], 1u);
            const unsigned tg = og / nx;
            if (og + 1u == (tg + 1u) * nx) xb_add(&bar[XB_TOPGEN], 1u);
            else XB_SPIN(xb_ld(&bar[XB_TOPGEN]) == tg, bar);
            __builtin_amdgcn_fence(__ATOMIC_ACQUIRE, "agent");
            xb_add(&bar[XB_XGEN(b.x)], 1u);
            asm volatile("s_waitcnt vmcnt(0)" ::: "memory");
        } else {
            XB_SPIN(xb_ld(&bar[XB_XGEN(b.x)]) == gen, bar);
            __builtin_amdgcn_fence(__ATOMIC_ACQUIRE, "agent");
            asm volatile("s_waitcnt vmcnt(0)" ::: "memory");
        }
    }
    __syncthreads();
}

#ifndef MK_MULTI
#define MK_MULTI 0
#endif
constexpr int N_PHASES = 6;
constexpr int CW_BAR = 4096;
#ifndef PROBE_PHASE
#define PROBE_PHASE (-1)
#endif
#define REPS(k) for (int rep_ = 0; rep_ < ((PROBE_PHASE) == (k) ? 2 : 1); ++rep_)
__global__ void __launch_bounds__(512, 2) mk_fwd(Params P, int ph_lo, int ph_hi) {
    extern __shared__ __attribute__((aligned(16))) unsigned char lds_raw[];
    LAS unsigned char* lds = (LAS unsigned char*)lds_raw;
    const int tid = threadIdx.x, lane = tid & 63, wave = __builtin_amdgcn_readfirstlane(tid >> 6), bid = blockIdx.x, G = gridDim.x;
    volatile LAS unsigned* bst = (volatile LAS unsigned*)(lds + LDS_MISC + 32);
    if (tid < 2) bst[tid] = 0u;
    __syncthreads();
    XcdBarrier xbar = xcd_barrier_post((unsigned*)(P.ws + OFF_CTL) + CW_BAR, bst);
#define IN(k) (ph_lo <= (k) && (k) < ph_hi)
#define SEAM(k) do { if (IN(k) && IN((k) + 1)) xcd_barrier(xbar); } while (0)
    if (IN(0)) REPS(0) phase0a(P, lds, tid, lane, wave, bid, G);
    SEAM(0);
    if (IN(1)) REPS(1) phase0b(P, lane, wave, bid, G);
    SEAM(1);
    if (IN(2)) REPS(2) {
        pg8::Gemm gm{(const bf16_t*)(P.ws + OFF_H), (const bf16_t*)(P.ws + OFF_WTIN), NTOK, 4096, 1024}; pg8::StaticOrder S; S.init(NTOK, 4096, G, bid);
        EpiIn E{(bf16_t*)(P.ws + OFF_PROJ), P.qg, P.kg, (const float*)(P.ws + OFF_ROPE), (const float*)(P.ws + OFF_ROPE) + 16384 * 64};
        pg8::gemm_phase<EpiIn, pg8::StaticOrder, true, true>(lds, gm, S, E);
    }
    SEAM(2);
    if (IN(3)) REPS(3) {
        unsigned* ctr = (unsigned*)(P.ws + OFF_CTL) + 64 * rep_;
        LAS unsigned* misc = (LAS unsigned*)(lds + LDS_MISC);
        for (;;) {
            __syncthreads();
            if (tid == 0) misc[0] = atomicAdd(ctr, 1u);
            __syncthreads();
            const int unit = (int)misc[0];
            if (unit >= SCAN_UNITS + 512 + 256) break;
            if (unit < SCAN_UNITS) scan_unit(P, lds, unit >> 4, (unit >> 2) & 3, (unit >> 1) & 1, unit & 1, tid, lane, wave);
            else { const int j = unit - SCAN_UNITS - 512; const bool full = j < 0; na_strip(P, lds, full ? unit - SCAN_UNITS : 512 + (j >> 1), full ? -1 : (j & 1), tid, lane, wave); }
        }
    }
    SEAM(3);
    if (IN(4)) REPS(4) ret_phase(P, lds, tid, lane, wave, bid, G);
    SEAM(4);
    if (IN(5)) REPS(5) {
        pg8::Gemm gm{(const bf16_t*)(P.ws + OFF_MIX), (const bf16_t*)(P.ws + OFF_WTOUT), NTOK, 1024, 1024}; pg8::StaticOrder S; S.init(NTOK, 1024, G, bid);
        EpiOut E{P.xp, P.xs, (const float*)(P.ws + OFF_MOD), P.out};
        pg8::gemm_phase<EpiOut, pg8::StaticOrder, true, true>(lds, gm, S, E);
    }
#undef IN
#undef SEAM
}

extern "C" void kernel_launch(void* const* d_in, const int* in_sizes, int n_in, void* d_out, int out_size, void* d_ws, size_t ws_size, hipStream_t stream) {
    static int grid = 0;
    if (grid == 0) {
        if (n_in != 15 || ws_size < WS_NEED) { fprintf(stderr, "kernel_launch: unexpected n_in %d / ws_size %zu\n", n_in, ws_size); grid = -1; return; }
        int dev = 0, cus = 0, per_cu = 0;
        hipGetDevice(&dev); hipDeviceGetAttribute(&cus, hipDeviceAttributeMultiprocessorCount, dev);
        if (hipFuncSetAttribute((const void*)mk_fwd, hipFuncAttributeMaxDynamicSharedMemorySize, LDS_BYTES) != hipSuccess) { fprintf(stderr, "kernel_launch: hipFuncSetAttribute failed\n"); grid = -1; return; }
        if (hipOccupancyMaxActiveBlocksPerMultiprocessor(&per_cu, (const void*)mk_fwd, 512, LDS_BYTES) != hipSuccess || per_cu < 1) { fprintf(stderr, "kernel_launch: occupancy query gave %d\n", per_cu); grid = -1; (void)hipGetLastError(); return; }
        grid = cus * per_cu;
    }
    if (grid < 0) return;
    (void)hipMemsetAsync((char*)d_ws + OFF_CTL, 0, 32768, stream);
    Params p{};
    p.xp = (const float*)d_in[0]; p.xs = (const float*)d_in[1]; p.cp = (const float*)d_in[2]; p.csm = (const float*)d_in[3];
    p.norm_gain = (const float*)d_in[4]; p.w_ada = (const float*)d_in[5]; p.b_ada = (const float*)d_in[6]; p.w_in = (const float*)d_in[7];
    p.qg = (const float*)d_in[8]; p.kg = (const float*)d_in[9]; p.rpb = (const float*)d_in[10]; p.dec_f = (const float*)d_in[11]; p.dec_b = (const float*)d_in[12];
    p.rgain = (const float*)d_in[13]; p.w_out = (const float*)d_in[14];
    p.out = (float*)d_out; p.ws = (unsigned char*)d_ws;
#if MK_MULTI
    for (int k = 0; k < N_PHASES; ++k) { int lo = k, hi = k + 1; void* args[] = {&p, &lo, &hi};
        hipError_t e = hipLaunchCooperativeKernel((const void*)mk_fwd, dim3(grid), dim3(512), args, LDS_BYTES, stream);
        if (e != hipSuccess) { fprintf(stderr, "launch %d failed: %s\n", k, hipGetErrorString(e)); break; } }
#else
    int lo = 0, hi = N_PHASES; void* args[] = {&p, &lo, &hi};
    hipError_t e = hipLaunchCooperativeKernel((const void*)mk_fwd, dim3(grid), dim3(512), args, LDS_BYTES, stream);
    if (e != hipSuccess) fprintf(stderr, "cooperative launch failed: %s (grid %d)\n", hipGetErrorString(e), grid);
#endif
}
```

```cpp
#include <hip/hip_runtime.h>
#include <hip/hip_cooperative_groups.h>
#include <cstdio>
#include <cstdint>
namespace cg = cooperative_groups;
namespace pg8 {
#define PG8_LAS __attribute__((address_space(3)))
typedef unsigned short bf16_t;
typedef short bf16x8 __attribute__((ext_vector_type(8)));
typedef float f32x4 __attribute__((ext_vector_type(4)));
typedef unsigned u32x4 __attribute__((ext_vector_type(4)));
constexpr int BM = 256, BK = 64, HALF = 128, HTB = HALF * BK * 2  , STAGE_BYTES = 8 * HTB, NXCD = 8, WGM = 4;

__host__ __device__ __forceinline__ int lds_byte(int r, int c) { const int st = (r >> 4) * 2 + (c >> 5), rr = r & 15, cc = c & 31, ob = rr * 64 + cc * 2; return st * 1024 + (ob ^ (((ob >> 9) & 1) << 5)); }
__host__ __device__ __forceinline__ void stage_rc(int b, int& R, int& C) { const int st = b / 1024, sb = b % 1024, swz = sb ^ (((sb >> 9) & 1) << 5); R = (st >> 1) * 16 + swz / 64; C = (st & 1) * 32 + (swz % 64) / 2; }
__host__ __device__ __forceinline__ int perm32(int rho) { const int n = rho >> 4, i = rho & 15; return 8 * (i >> 2) + 4 * n + (i & 3); }

struct Unit { int pm, pn; };
struct Gemm { const bf16_t* A; const bf16_t* Bt; int M, N, K; };

struct StaticOrder {
    int nM, nN, nwg, G, c;
    __host__ __device__ void init(int M, int N, int G_, int c_) { nM = M / BM; nN = N / BM; nwg = nM * nN; G = G_; c = c_; }
    __host__ __device__ bool next(int i, Unit& u) const {
        const long L = (long)i * G + c; if (L >= nwg) return false;
        int wgid = (int)L; { const int q = nwg / NXCD, r = nwg % NXCD, xcd = wgid % NXCD, off = wgid / NXCD; wgid = (xcd < r ? xcd * (q + 1) : r * (q + 1) + (xcd - r) * q) + off; }
        const int nig = WGM * nN, gid = wgid / nig, fm = gid * WGM, gsz = (nM - fm) < WGM ? (nM - fm) : WGM;
        u.pm = fm + ((wgid % nig) % gsz); u.pn = (wgid % nig) / gsz; return true;
    }
    __device__ __forceinline__ void a_ready(const Unit&) const {}
    __device__ __forceinline__ void done(const Unit&) const {}
};

__device__ __forceinline__ unsigned cvt_pk_bf16(float lo, float hi) { unsigned r; asm volatile("v_cvt_pk_bf16_f32 %0, %1, %2" : "=v"(r) : "v"(lo), "v"(hi)); return r; }
template <class Epi, class Sched, bool ALIGN_EPI = false, bool SP2 = false>
__device__ __forceinline__ void gemm_phase(PG8_LAS unsigned char* lds, const Gemm g, const Sched& S, const Epi& E) {
    const int tid = threadIdx.x, wid = __builtin_amdgcn_readfirstlane(tid >> 6), lane = tid & 63, wr = wid >> 2, wc = wid & 3, fr = lane & 15, fq = lane >> 4;
    const int K = g.K, nt = K / BK;
    unsigned voffA[2], voffB[2];
#pragma unroll
    for (int i = 0; i < 2; ++i) { int R, C; stage_rc(tid * 16 + i * 8192, R, C); const int Rb = Epi::PERM ? ((R & ~31) + perm32(R & 31)) : R;
        voffA[i] = (unsigned)(R * K + C) * 2u; voffB[i] = (unsigned)(Rb * K + C) * 2u; }
    const size_t kstep = (size_t)(BK * 2);
    const size_t hstep = (size_t)HALF * K * 2;
    const size_t tstep = 2 * hstep;
    const unsigned ldsw = (unsigned)wid * 1024u;
    const int aoff = lds_byte(wr * 64 + fr, fq * 8), boff = lds_byte(wc * 32 + fr, fq * 8);
#define PG8_SA(b, h) (((b) * 2 + (h)) * HTB)
#define PG8_SB(b, h) ((4 + (b) * 2 + (h)) * HTB)
#define PG8_STAGE(bufoff, gbase, voff) do { _Pragma("unroll") for (int _i = 0; _i < 2; ++_i) \
        __builtin_amdgcn_global_load_lds((const unsigned*)((const char*)(gbase) + (voff)[_i]), (PG8_LAS unsigned*)(lds + (bufoff) + ldsw + _i * 8192), 16, 0, 0); } while (0)
#define PG8_LDA(dst, b, h) do { _Pragma("unroll") for (int m = 0; m < 4; ++m) _Pragma("unroll") for (int k = 0; k < 2; ++k) dst[m][k] = *(const PG8_LAS bf16x8*)(lds + PG8_SA(b, h) + aoff + m * 2048 + k * 1024); } while (0)
#define PG8_LDB(dst, b, h) do { _Pragma("unroll") for (int n = 0; n < 2; ++n) _Pragma("unroll") for (int k = 0; k < 2; ++k) dst[n][k] = *(const PG8_LAS bf16x8*)(lds + PG8_SB(b, h) + boff + n * 2048 + k * 1024); } while (0)
#define PG8_MMA(ai, bj, At, Bt) do { __builtin_amdgcn_s_setprio(1); _Pragma("unroll") for (int m = 0; m < 4; ++m) _Pragma("unroll") for (int n = 0; n < 2; ++n) _Pragma("unroll") for (int k = 0; k < 2; ++k) \
        acc[ai][bj][m][n] = __builtin_amdgcn_mfma_f32_16x16x32_bf16(Bt[n][k], At[m][k], acc[ai][bj][m][n], 0, 0, 0); __builtin_amdgcn_s_setprio(0); } while (0)
#define PG8_WAIT_V(n) asm volatile("s_waitcnt vmcnt(" #n ")" ::: "memory")
#define PG8_WAIT_L(n) asm volatile("s_waitcnt lgkmcnt(" #n ")" ::: "memory")
#define PG8_BAR __builtin_amdgcn_s_barrier()
#define PG8_SCHED __builtin_amdgcn_sched_barrier(0)
    Unit cur, nxt; int ui = 0;
    if (!S.next(0, cur)) return;
    f32x4 acc[2][2][4][2];
#pragma unroll
    for (int a = 0; a < 2; ++a)
#pragma unroll
        for (int b = 0; b < 2; ++b)
#pragma unroll
            for (int m = 0; m < 4; ++m)
#pragma unroll
                for (int n = 0; n < 2; ++n) acc[a][b][m][n] = (f32x4){0.f, 0.f, 0.f, 0.f};
    bf16x8 At[4][2], B0[2][2], B1[2][2];
    const char* cA = (const char*)g.A + (size_t)cur.pm * tstep; const char* cB = (const char*)g.Bt + (size_t)cur.pn * tstep;
    S.a_ready(cur);
    if constexpr (SP2) {
        PG8_STAGE(PG8_SB(0, 0), cB, voffB); PG8_STAGE(PG8_SB(0, 1), cB + hstep, voffB); PG8_STAGE(PG8_SA(0, 0), cA, voffA); PG8_STAGE(PG8_SA(0, 1), cA + hstep, voffA);
        if (wr == 1) PG8_BAR;
        PG8_WAIT_V(2); PG8_BAR;
        PG8_STAGE(PG8_SB(1, 0), cB + kstep, voffB); PG8_STAGE(PG8_SA(1, 0), cA + kstep, voffA); PG8_STAGE(PG8_SB(1, 1), cB + hstep + kstep, voffB);
        PG8_WAIT_V(6); PG8_BAR;
    } else {
        PG8_STAGE(PG8_SB(0, 0), cB, voffB); PG8_STAGE(PG8_SA(0, 0), cA, voffA); PG8_STAGE(PG8_SB(0, 1), cB + hstep, voffB); PG8_STAGE(PG8_SA(0, 1), cA + hstep, voffA);
        if (wr == 1) PG8_BAR;
        PG8_WAIT_V(4); PG8_BAR;
        PG8_STAGE(PG8_SB(1, 0), cB + kstep, voffB); PG8_STAGE(PG8_SA(1, 0), cA + kstep, voffA); PG8_STAGE(PG8_SB(1, 1), cB + hstep + kstep, voffB);
        PG8_WAIT_V(6); PG8_BAR;
    }
    for (;;) {
        const bool has_next = S.next(ui + 1, nxt);
        const char* nA = has_next ? (const char*)g.A + (size_t)nxt.pm * tstep : cA; const char* nB = has_next ? (const char*)g.Bt + (size_t)nxt.pn * tstep : cB;
        for (int t = 0; t < nt; t += 2) {
            const bool last = (t == nt - 2);
            const char* a1 = cA + (size_t)(t + 1) * kstep;
            const char* a2 = last ? nA : cA + (size_t)(t + 2) * kstep; const char* b2 = last ? nB : cB + (size_t)(t + 2) * kstep;
            const char* a3 = a2 + kstep; const char* b3 = b2 + kstep;
            if (last && has_next) S.a_ready(nxt);
            if constexpr (SP2) {
            PG8_LDB(B0, 0, 0); PG8_LDB(B1, 0, 1); PG8_SCHED; PG8_LDA(At, 0, 0); PG8_STAGE(PG8_SA(1, 1), a1 + hstep, voffA);
            PG8_WAIT_V(8); PG8_WAIT_L(0); PG8_BAR; PG8_MMA(0, 0, At, B0); PG8_MMA(0, 1, At, B1); PG8_BAR; PG8_SCHED;
            PG8_LDA(At, 0, 1); PG8_STAGE(PG8_SB(0, 0), b2, voffB); PG8_STAGE(PG8_SB(0, 1), b2 + hstep, voffB); PG8_STAGE(PG8_SA(0, 0), a2, voffA);
            PG8_WAIT_V(8); PG8_WAIT_L(0); PG8_BAR; PG8_MMA(1, 0, At, B0); PG8_MMA(1, 1, At, B1); PG8_BAR; PG8_SCHED;
            PG8_LDB(B0, 1, 0); PG8_LDB(B1, 1, 1); PG8_SCHED; PG8_LDA(At, 1, 0); PG8_STAGE(PG8_SA(0, 1), a2 + hstep, voffA);
            PG8_WAIT_V(8); PG8_WAIT_L(0); PG8_BAR; PG8_MMA(0, 0, At, B0); PG8_MMA(0, 1, At, B1); PG8_BAR; PG8_SCHED;
            PG8_LDA(At, 1, 1); PG8_STAGE(PG8_SB(1, 0), b3, voffB); PG8_STAGE(PG8_SB(1, 1), b3 + hstep, voffB); PG8_STAGE(PG8_SA(1, 0), a3, voffA);
            PG8_WAIT_V(8); PG8_WAIT_L(0); PG8_BAR; PG8_MMA(1, 0, At, B0); PG8_MMA(1, 1, At, B1); PG8_BAR; PG8_SCHED;
            } else {
            PG8_LDB(B0, 0, 0); PG8_SCHED; PG8_LDA(At, 0, 0); PG8_STAGE(PG8_SA(1, 1), a1 + hstep, voffA);
            PG8_WAIT_L(8); PG8_BAR; PG8_WAIT_L(0); PG8_MMA(0, 0, At, B0); PG8_BAR; PG8_SCHED;
            PG8_LDB(B1, 0, 1); PG8_STAGE(PG8_SB(0, 0), b2, voffB);
            PG8_BAR; PG8_WAIT_L(0); PG8_MMA(0, 1, At, B1); PG8_BAR;
            PG8_LDA(At, 0, 1); PG8_STAGE(PG8_SA(0, 0), a2, voffA);
            PG8_BAR; PG8_WAIT_L(0); PG8_MMA(1, 0, At, B0); PG8_BAR; PG8_SCHED;
            PG8_STAGE(PG8_SB(0, 1), b2 + hstep, voffB);
            PG8_WAIT_V(6); PG8_BAR; PG8_MMA(1, 1, At, B1); PG8_BAR;
            PG8_LDB(B0, 1, 0); PG8_SCHED; PG8_LDA(At, 1, 0); PG8_STAGE(PG8_SA(0, 1), a2 + hstep, voffA);
            PG8_WAIT_L(8); PG8_BAR; PG8_WAIT_L(0); PG8_MMA(0, 0, At, B0); PG8_BAR; PG8_SCHED;
            PG8_LDB(B1, 1, 1); PG8_STAGE(PG8_SB(1, 0), b3, voffB);
            PG8_BAR; PG8_WAIT_L(0); PG8_MMA(0, 1, At, B1); PG8_BAR;
            PG8_LDA(At, 1, 1); PG8_STAGE(PG8_SA(1, 0), a3, voffA);
            PG8_BAR; PG8_WAIT_L(0); PG8_MMA(1, 0, At, B0); PG8_BAR; PG8_SCHED;
            PG8_STAGE(PG8_SB(1, 1), b3 + hstep, voffB);
            PG8_WAIT_V(6); PG8_BAR; PG8_MMA(1, 1, At, B1); PG8_BAR;
            }
        }
        if constexpr (ALIGN_EPI) { if (wr == 0) PG8_BAR; }
        if constexpr (!Epi::AFTER_DRAIN) { E(acc, cur, wr, wc, fr, fq); S.done(cur); }
        if (!has_next) break;
#pragma unroll
        for (int a = 0; a < 2; ++a)
#pragma unroll
            for (int b = 0; b < 2; ++b)
#pragma unroll
                for (int m = 0; m < 4; ++m)
#pragma unroll
                    for (int n = 0; n < 2; ++n) acc[a][b][m][n] = (f32x4){0.f, 0.f, 0.f, 0.f};
        cur = nxt; cA = nA; cB = nB; ++ui;
        if constexpr (ALIGN_EPI) { if (wr == 1) PG8_BAR; }
    }
    PG8_WAIT_V(0);
    if constexpr (!ALIGN_EPI) { if (wr == 0) PG8_BAR; }
    PG8_BAR;
    if constexpr (Epi::AFTER_DRAIN) { E.fused(acc, cur, wr, wc, fr, fq, lds, wid, lane); S.done(cur); }
#undef PG8_SA
#undef PG8_SB
#undef PG8_STAGE
#undef PG8_LDA
#undef PG8_LDB
#undef PG8_MMA
#undef PG8_WAIT_V
#undef PG8_WAIT_L
#undef PG8_BAR
#undef PG8_SCHED
}
}

#define LAS __attribute__((address_space(3)))
using pg8::bf16_t; using pg8::bf16x8; using pg8::f32x4; using pg8::u32x4; using pg8::cvt_pk_bf16;
typedef short s16x4 __attribute__((ext_vector_type(4)));
typedef unsigned u32x2 __attribute__((ext_vector_type(2)));

constexpr int NTOK = 81920, NP = 65536, DM = 1024;
constexpr float LOG2E = 1.4426950408889634f;
constexpr float EPS = 1e-6f;
constexpr size_t MiB = (size_t)1 << 20;
constexpr size_t OFF_CTL = 0, OFF_MOD = 64 * 1024, OFF_ROPE = 1 * MiB, OFF_WTIN = 16 * MiB, OFF_WTOUT = 24 * MiB, OFF_H = 32 * MiB, OFF_MIX = 32 * MiB,
                 OFF_PROJ = 192 * MiB, OFF_ST = 832 * MiB, OFF_FIN = 992 * MiB, WS_NEED = 1000 * MiB;
constexpr size_t SEC_STRIDE = (size_t)NTOK * 512;
constexpr int LDS_BYTES = 152 * 1024, LDS_MISC = 150 * 1024;
constexpr int SCAN_UNITS = 320, RET_UNITS = 640 * 4;

struct Params {
    const float* xp; const float* xs; const float* cp; const float* csm;
    const float* norm_gain; const float* w_ada; const float* b_ada; const float* w_in;
    const float* qg; const float* kg; const float* rpb; const float* dec_f; const float* dec_b; const float* rgain; const float* w_out;
    float* out; unsigned char* ws;
};

__device__ __forceinline__ float bf_lo(unsigned u) { return __uint_as_float(u << 16); }
__device__ __forceinline__ float bf_hi(unsigned u) { return __uint_as_float(u & 0xffff0000u); }
__device__ __forceinline__ float silu_f(float x) { return x * __builtin_amdgcn_rcpf(1.f + __expf(-x)); }
__device__ __forceinline__ unsigned off256(unsigned row, unsigned ch) { return 256u * row + 16u * (ch ^ (((row & 3u) << 2) | ((row >> 2) & 3u))); }
__device__ __forceinline__ unsigned sw128(unsigned row) { return ((row >> 1) & 1u) | (((row >> 3) & 1u) << 1); }
__device__ __forceinline__ s16x4 tr_read(const LAS unsigned char* p) { return __builtin_amdgcn_ds_read_tr16_b64_v4i16((LAS s16x4*)p); }
__device__ __forceinline__ bf16x8 cat8(s16x4 a, s16x4 b) { return (bf16x8){a[0], a[1], a[2], a[3], b[0], b[1], b[2], b[3]}; }
__device__ __forceinline__ f32x4 mfma16(bf16x8 a, bf16x8 b, f32x4 c) { return __builtin_amdgcn_mfma_f32_16x16x32_bf16(a, b, c, 0, 0, 0); }
__device__ __forceinline__ float wave_sum(float v) {
#pragma unroll
    for (int o = 1; o < 64; o <<= 1) v += __shfl_xor(v, o);
    return v;
}
__device__ __forceinline__ float row4_sum(float v) {
    auto a = __builtin_amdgcn_permlane16_swap(__float_as_uint(v), __float_as_uint(v), false, false); v = __uint_as_float(a[0]) + __uint_as_float(a[1]);
    auto b = __builtin_amdgcn_permlane32_swap(__float_as_uint(v), __float_as_uint(v), false, false); return __uint_as_float(b[0]) + __uint_as_float(b[1]);
}
typedef float f32x2c __attribute__((ext_vector_type(2)));
__device__ __forceinline__ u32x4 fp8x8_to_bf16x8(unsigned u0, unsigned u1) {
    const f32x2c a = __builtin_amdgcn_cvt_pk_f32_fp8((int)u0, false), b = __builtin_amdgcn_cvt_pk_f32_fp8((int)u0, true);
    const f32x2c c = __builtin_amdgcn_cvt_pk_f32_fp8((int)u1, false), d = __builtin_amdgcn_cvt_pk_f32_fp8((int)u1, true);
    u32x4 o; o.x = cvt_pk_bf16(a.x, a.y); o.y = cvt_pk_bf16(b.x, b.y); o.z = cvt_pk_bf16(c.x, c.y); o.w = cvt_pk_bf16(d.x, d.y); return o;
}
#define LDS_WAIT() asm volatile("s_waitcnt lgkmcnt(0)" ::: "memory")
#define LBAR() asm volatile("s_waitcnt lgkmcnt(0)\n\ts_barrier" ::: "memory")

__device__ __forceinline__ void transpose_item(const float* W, int K, int N, bf16_t* WT, int src_col0, int dst_row0, int k0, LAS float* scr, int lane) {
#pragma unroll 8
    for (int i = 0; i < 32; ++i) { const int kk = 2 * i + (lane >> 5); scr[kk * 33 + (lane & 31)] = W[(size_t)(k0 + kk) * N + src_col0 + (lane & 31)]; }
    LDS_WAIT();
    const int c = lane & 7;
#pragma unroll
    for (int j = 0; j < 4; ++j) { const int n = (lane >> 3) + 8 * j; const LAS float* s = scr + (8 * c) * 33 + n;
        u32x4 o; o.x = cvt_pk_bf16(s[0 * 33], s[1 * 33]); o.y = cvt_pk_bf16(s[2 * 33], s[3 * 33]); o.z = cvt_pk_bf16(s[4 * 33], s[5 * 33]); o.w = cvt_pk_bf16(s[6 * 33], s[7 * 33]);
        *(u32x4*)(WT + (size_t)(dst_row0 + n) * K + k0 + 8 * c) = o; }
    LDS_WAIT();
}

__device__ __forceinline__ void phase0a(const Params& P, LAS unsigned char* lds, int tid, int lane, int wave, int bid, int G) {
    float* mod = (float*)(P.ws + OFF_MOD);
    for (int it = bid; it < 96; it += G) {
        LAS float* sc = (LAS float*)lds;
        LAS float* red = (LAS float*)(lds + 72 * 1024);
        for (int i = tid; i < 17 * 1024; i += 512) { const float c = i < 16 * 1024 ? P.cp[i] : P.csm[i - 16 * 1024]; sc[i] = silu_f(c); }
        __syncthreads();
        const int cl = tid & 31, kg = tid >> 5, col = it * 32 + cl;
        float acc[17];
#pragma unroll
        for (int s = 0; s < 17; ++s) acc[s] = 0.f;
#pragma unroll 8
        for (int kk = 0; kk < 64; ++kk) { const int k = kg * 64 + kk; const float w = P.w_ada[(size_t)k * 3072 + col];
#pragma unroll
            for (int s = 0; s < 17; ++s) acc[s] += sc[s * 1024 + k] * w; }
#pragma unroll
        for (int s = 0; s < 17; ++s) red[(kg * 17 + s) * 32 + cl] = acc[s];
        __syncthreads();
        for (int i = tid; i < 17 * 32; i += 512) { const int s = i >> 5, c2 = i & 31; float v = P.b_ada[it * 32 + c2];
#pragma unroll
            for (int k2 = 0; k2 < 16; ++k2) v += red[(k2 * 17 + s) * 32 + c2];
            mod[s * 3072 + it * 32 + c2] = v; }
        __syncthreads();
    }
    LAS float* scr = (LAS float*)(lds + wave * 16384);
    const int nskip = G >= 192 ? 96 : 0;
    if (bid < nskip) return;
    const int gw = (bid - nskip) * 8 + wave, NGW = (G - nskip) * 8;
    bf16_t* WtIn = (bf16_t*)(P.ws + OFF_WTIN); bf16_t* WtOut = (bf16_t*)(P.ws + OFF_WTOUT);
    constexpr int I_IN = 16 * 128, I_OUT = 16 * 32;
    for (int it = gw; it < I_IN + I_OUT; it += NGW) {
        if (it < I_IN) {
            const int kb = it >> 7, n0 = (it & 127) * 32;
            const int pn = n0 >> 8, bj = (n0 >> 7) & 1, wc = (n0 >> 5) & 3, sec = pn >> 1, half = pn & 1;
            const int tc = (sec == 4 || sec == 5) ? 128 * (wc >> 1) + 64 * bj + 32 * (wc & 1) : 64 * wc + 32 * bj;
            transpose_item(P.w_in, 1024, 4096, WtIn, 512 * sec + 256 * half + tc, n0, kb * 64, scr, lane);
        } else {
            const int r = it - I_IN, kb = r >> 5, n0 = (r & 31) * 32;
            transpose_item(P.w_out, 1024, 1024, WtOut, n0, n0, kb * 64, scr, lane);
        }
    }
    float* ropec = (float*)(P.ws + OFF_ROPE); float* ropes = ropec + 16384 * 64;
    for (int t = gw; t < 16384; t += NGW) {
        double r = 0.8659643233600653, inv = 1.0;
#pragma unroll
        for (int b = 0; b < 6; ++b) { if ((lane >> b) & 1) inv *= r; r *= r; }
        const double ang = (double)t * inv, rev = ang * 0.15915494309189535, fr = rev - rint(rev), x = fr * 6.283185307179586, x2 = x * x;
        double sn = 1.0, cs = 1.0;
#pragma unroll
        for (int k = 14; k >= 1; --k) { sn = 1.0 - x2 * (1.0 / ((2.0 * k) * (2.0 * k + 1.0))) * sn; cs = 1.0 - x2 * (1.0 / ((2.0 * k - 1.0) * (2.0 * k))) * cs; }
        sn *= x;
        ropec[t * 64 + lane] = (float)cs; ropes[t * 64 + lane] = (float)sn;
    }
}

__device__ __forceinline__ void phase0b(const Params& P, int lane, int wave, int bid, int G) {
    const float* mod = (const float*)(P.ws + OFF_MOD); bf16_t* H = (bf16_t*)(P.ws + OFF_H);
    const int gw = bid * 8 + wave, NGW = G * 8;
    f32x4 v[2][4], vn[2][4];
#define P0B_LOAD(dst_, r0_) do { _Pragma("unroll") for (int rr = 0; rr < 2; ++rr) { const int row = min((r0_) + rr * NGW, NTOK - 1); \
            const float* xr = row < NP ? P.xp + (size_t)row * DM : P.xs + (size_t)(row - NP) * DM; \
            _Pragma("unroll") for (int j = 0; j < 4; ++j) dst_[rr][j] = *(const f32x4*)(xr + 8 * lane + 512 * (j >> 1) + 4 * (j & 1)); } } while (0)
    P0B_LOAD(v, gw);
    for (int row0 = gw; row0 < NTOK; row0 += 2 * NGW) {
        P0B_LOAD(vn, row0 + 2 * NGW);
        asm volatile("" ::: "memory");
        float ss[2];
#pragma unroll
        for (int rr = 0; rr < 2; ++rr) { float s2 = 0.f;
#pragma unroll
            for (int j = 0; j < 4; ++j) s2 += (v[rr][j].x * v[rr][j].x + v[rr][j].y * v[rr][j].y) + (v[rr][j].z * v[rr][j].z + v[rr][j].w * v[rr][j].w);
            ss[rr] = s2; }
#pragma unroll
        for (int rr = 0; rr < 2; ++rr) { const int row = row0 + rr * NGW; if (row >= NTOK) break;
            const int s = row < NP ? (row >> 12) : 16; const float* md = mod + s * 3072;
            const float rstd = rsqrtf(wave_sum(ss[rr]) * (1.f / DM) + EPS);
#pragma unroll
            for (int jj = 0; jj < 2; ++jj) { const int c = 8 * lane + 512 * jj; f32x4 hv[2];
#pragma unroll
                for (int e = 0; e < 2; ++e) { const f32x4 gn = *(const f32x4*)(P.norm_gain + c + 4 * e), sh = *(const f32x4*)(md + c + 4 * e), scv = *(const f32x4*)(md + 1024 + c + 4 * e);
                    hv[e] = (v[rr][2 * jj + e] * rstd * gn) * (scv + 1.f) + sh; }
                u32x4 o; o.x = cvt_pk_bf16(hv[0].x, hv[0].y); o.y = cvt_pk_bf16(hv[0].z, hv[0].w); o.z = cvt_pk_bf16(hv[1].x, hv[1].y); o.w = cvt_pk_bf16(hv[1].z, hv[1].w);
                *(u32x4*)(H + (size_t)row * DM + c) = o; } }
#pragma unroll
        for (int rr = 0; rr < 2; ++rr)
#pragma unroll
            for (int j = 0; j < 4; ++j) v[rr][j] = vn[rr][j];
    }
#undef P0B_LOAD
}

struct EpiIn {
    static constexpr bool PERM = true, AFTER_DRAIN = false;
    bf16_t* proj; const float* qg; const float* kg; const float* ropec; const float* ropes;
    __device__ __forceinline__ void operator()(const f32x4 (&acc)[2][2][4][2], const pg8::Unit& u, int wr, int wc, int fr, int fq) const {
        const int sec = u.pn >> 1, half = u.pn & 1;
        bf16_t* base = proj + (size_t)sec * SEC_STRIDE;
        const int row0 = u.pm * 256 + wr * 64 + fr;
        if (sec <= 1) {
            const float* gn = sec == 0 ? qg : kg; const float osc = sec == 0 ? 0.125f * LOG2E : 1.f;
            f32x4 g[2][2];
#pragma unroll
            for (int bj = 0; bj < 2; ++bj)
#pragma unroll
                for (int n = 0; n < 2; ++n) g[bj][n] = *(const f32x4*)(gn + 32 * bj + 8 * fq + 4 * n);
            const int col0 = 256 * half + 64 * wc + 8 * fq;
#pragma unroll
            for (int ai = 0; ai < 2; ++ai)
#pragma unroll
                for (int m = 0; m < 4; ++m) {
                    float ss = 0.f;
#pragma unroll
                    for (int bj = 0; bj < 2; ++bj)
#pragma unroll
                        for (int n = 0; n < 2; ++n) { const f32x4 x = acc[ai][bj][m][n]; ss += (x[0] * x[0] + x[1] * x[1]) + (x[2] * x[2] + x[3] * x[3]); }
                    ss = row4_sum(ss);
                    const float r = rsqrtf(ss * (1.f / 64.f) + EPS) * osc;
                    bf16_t* rowp = base + (size_t)(row0 + ai * 128 + m * 16) * 512 + col0;
#pragma unroll
                    for (int bj = 0; bj < 2; ++bj) { const f32x4 v0 = acc[ai][bj][m][0] * r * g[bj][0], v1 = acc[ai][bj][m][1] * r * g[bj][1];
                        u32x4 w; w.x = cvt_pk_bf16(v0[0], v0[1]); w.y = cvt_pk_bf16(v0[2], v0[3]); w.z = cvt_pk_bf16(v1[0], v1[1]); w.w = cvt_pk_bf16(v1[2], v1[3]);
                        *(u32x4*)(rowp + 32 * bj) = w; }
                }
        } else if (sec == 4 || sec == 5) {
            const float osc = sec == 5 ? 0.08838834764831845f : 1.f;
            const int col0 = 256 * half + 128 * (wc >> 1) + 32 * (wc & 1) + 8 * fq, i0 = 32 * (wc & 1) + 8 * fq;
            const int tb = row0 < NP ? (row0 & 4095) : row0 - NP;
            f32x4 c[2], sn[2], c16[2], s16[2];
#pragma unroll
            for (int e = 0; e < 2; ++e) { c[e] = *(const f32x4*)(ropec + tb * 64 + i0 + 4 * e); sn[e] = *(const f32x4*)(ropes + tb * 64 + i0 + 4 * e);
                c16[e] = *(const f32x4*)(ropec + 16 * 64 + i0 + 4 * e); s16[e] = *(const f32x4*)(ropes + 16 * 64 + i0 + 4 * e); }
            asm volatile("" ::: "memory");
#pragma unroll
            for (int k = 0; k < 12; ++k) {
                if (k < 4 || k >= 8) {
                    const int ai = k >> 3, m = k & 3;
                    const int row = row0 + ai * 128 + m * 16;
                    const f32x4 c0 = c[0] * osc, c1 = c[1] * osc, s0 = sn[0] * osc, s1 = sn[1] * osc;
                    const f32x4 a0 = acc[ai][0][m][0], a1 = acc[ai][0][m][1], b0 = acc[ai][1][m][0], b1 = acc[ai][1][m][1];
                    const f32x4 o10 = a0 * c0 - b0 * s0, o11 = a1 * c1 - b1 * s1, o20 = a0 * s0 + b0 * c0, o21 = a1 * s1 + b1 * c1;
                    bf16_t* rowp = base + (size_t)row * 512 + col0;
                    u32x4 w; w.x = cvt_pk_bf16(o10[0], o10[1]); w.y = cvt_pk_bf16(o10[2], o10[3]); w.z = cvt_pk_bf16(o11[0], o11[1]); w.w = cvt_pk_bf16(o11[2], o11[3]);
                    *(u32x4*)(rowp) = w;
                    w.x = cvt_pk_bf16(o20[0], o20[1]); w.y = cvt_pk_bf16(o20[2], o20[3]); w.z = cvt_pk_bf16(o21[0], o21[1]); w.w = cvt_pk_bf16(o21[2], o21[3]);
                    *(u32x4*)(rowp + 64) = w;
                }
                if (k < 11) {
#pragma unroll
                    for (int e = 0; e < 2; ++e) { const f32x4 cn = c[e] * c16[e] - sn[e] * s16[e]; sn[e] = sn[e] * c16[e] + c[e] * s16[e]; c[e] = cn; } }
            }
        } else {
            const bool act = (sec == 3 || sec == 7);
            const int col0 = 256 * half + 64 * wc + 8 * fq;
#pragma unroll
            for (int ai = 0; ai < 2; ++ai)
#pragma unroll
                for (int m = 0; m < 4; ++m) {
                    bf16_t* rowp = base + (size_t)(row0 + ai * 128 + m * 16) * 512 + col0;
#pragma unroll
                    for (int bj = 0; bj < 2; ++bj) { f32x4 v0 = acc[ai][bj][m][0], v1 = acc[ai][bj][m][1];
                        if (act) { v0 = (f32x4){silu_f(v0[0]), silu_f(v0[1]), silu_f(v0[2]), silu_f(v0[3])}; v1 = (f32x4){silu_f(v1[0]), silu_f(v1[1]), silu_f(v1[2]), silu_f(v1[3])}; }
                        u32x4 w; w.x = cvt_pk_bf16(v0[0], v0[1]); w.y = cvt_pk_bf16(v0[2], v0[3]); w.z = cvt_pk_bf16(v1[0], v1[1]); w.w = cvt_pk_bf16(v1[2], v1[3]);
                        *(u32x4*)(rowp + 32 * bj) = w; }
                }
        }
    }
};
struct EpiOut {
    static constexpr bool PERM = true, AFTER_DRAIN = false;
    const float* xp; const float* xs; const float* mod; float* out;
    __device__ __forceinline__ void operator()(const f32x4 (&acc)[2][2][4][2], const pg8::Unit& u, int wr, int wc, int fr, int fq) const {
        const int row0 = u.pm * 256 + wr * 64 + fr, col0 = u.pn * 256 + wc * 32 + 8 * fq;
        const int s = (u.pm * 256 < NP) ? ((u.pm * 256) >> 12) : 16;
        const float* gate = mod + s * 3072 + 2048;
        f32x4 gv[2][2];
#pragma unroll
        for (int bj = 0; bj < 2; ++bj)
#pragma unroll
            for (int n = 0; n < 2; ++n) gv[bj][n] = *(const f32x4*)(gate + col0 + 128 * bj + 4 * n);
        const float* xbase = (u.pm * 256 < NP) ? xp : xs - (size_t)NP * DM;
        f32x4 xv[2][2][2][2];
#define EO_LOAD(bt_) do { _Pragma("unroll") for (int mm = 0; mm < 2; ++mm) { const float* xr = xbase + (size_t)(row0 + ((bt_) >> 1) * 128 + (2 * ((bt_) & 1) + mm) * 16) * DM + col0; \
            _Pragma("unroll") for (int bj = 0; bj < 2; ++bj) _Pragma("unroll") for (int n = 0; n < 2; ++n) xv[(bt_) & 1][mm][bj][n] = *(const f32x4*)(xr + 128 * bj + 4 * n); } } while (0)
#define EO_STORE(bt_) do { _Pragma("unroll") for (int mm = 0; mm < 2; ++mm) { float* orow = out + (size_t)(row0 + ((bt_) >> 1) * 128 + (2 * ((bt_) & 1) + mm) * 16) * DM + col0; \
            _Pragma("unroll") for (int bj = 0; bj < 2; ++bj) _Pragma("unroll") for (int n = 0; n < 2; ++n) \
                *(f32x4*)(orow + 128 * bj + 4 * n) = xv[(bt_) & 1][mm][bj][n] + gv[bj][n] * acc[(bt_) >> 1][bj][2 * ((bt_) & 1) + mm][n]; } } while (0)
#define EO_FENCE() asm volatile("" ::: "memory")
        EO_LOAD(0); EO_FENCE(); EO_LOAD(1); EO_FENCE();
        EO_STORE(0); EO_FENCE(); EO_LOAD(2); EO_FENCE();
        EO_STORE(1); EO_FENCE(); EO_LOAD(3); EO_FENCE();
        EO_STORE(2); EO_FENCE(); EO_STORE(3);
#undef EO_LOAD
#undef EO_STORE
#undef EO_FENCE
    }
};

__device__ __forceinline__ void scan_unit(const Params& P, LAS unsigned char* lds, int vs, int h, int dir, int dvh, int tid, int lane, int wave) {
    const bf16_t* KR = (const bf16_t*)(P.ws + OFF_PROJ) + 5 * SEC_STRIDE; const bf16_t* VR = (const bf16_t*)(P.ws + OFF_PROJ) + 6 * SEC_STRIDE;
    bf16_t* ST = (bf16_t*)(P.ws + OFF_ST); bf16_t* FIN = (bf16_t*)(P.ws + OFF_FIN);
    const int cbase = vs * 32;
    const float lg2 = -__expf((dir ? P.dec_b : P.dec_f)[h]) * LOG2E;
    const float cd = exp2f(lg2 * 128.f);
    const int g = lane >> 4, l15 = lane & 15, q = l15 >> 2, p = lane & 3;
    const int dkt0 = 2 * (wave >> 1), dvt0 = 2 * (wave & 1);
    f32x4 acc[2][2];
#pragma unroll
    for (int a = 0; a < 2; ++a)
#pragma unroll
        for (int b = 0; b < 2; ++b) acc[a][b] = (f32x4){0.f, 0.f, 0.f, 0.f};
    u32x4 kA[4], vA[2], kB[4], vB[2];
#define SC_LOAD(KR_, VR_, c_) do { const size_t tok_ = (size_t)(cbase + (c_)) * 128; \
        _Pragma("unroll") for (int i_ = 0; i_ < 4; ++i_) { const int idx_ = tid + 512 * i_; KR_[i_] = *(const u32x4*)(KR + (tok_ + (idx_ >> 4)) * 512 + h * 128 + 8 * (idx_ & 15)); } \
        _Pragma("unroll") for (int i_ = 0; i_ < 2; ++i_) { const int idx_ = tid + 512 * i_; VR_[i_] = *(const u32x4*)(VR + (tok_ + (idx_ >> 3)) * 512 + h * 128 + 64 * dvh + 8 * (idx_ & 7)); } } while (0)
#define SC_STORE(KR_, VR_, buf_) do { LAS unsigned char* kb_ = lds + (buf_) * 49152; LAS unsigned char* vb_ = kb_ + 32768; \
        _Pragma("unroll") for (int i_ = 0; i_ < 4; ++i_) { const int idx_ = tid + 512 * i_; *(LAS u32x4*)(kb_ + off256(idx_ >> 4, idx_ & 15)) = KR_[i_]; } \
        _Pragma("unroll") for (int i_ = 0; i_ < 2; ++i_) { const int idx_ = tid + 512 * i_; const int row_ = idx_ >> 3, c16_ = idx_ & 7; \
            const float w_ = exp2f(lg2 * (float)(dir ? row_ : 127 - row_)); const u32x4 v_ = VR_[i_]; u32x4 o_; \
            o_.x = cvt_pk_bf16(bf_lo(v_.x) * w_, bf_hi(v_.x) * w_); o_.y = cvt_pk_bf16(bf_lo(v_.y) * w_, bf_hi(v_.y) * w_); \
            o_.z = cvt_pk_bf16(bf_lo(v_.z) * w_, bf_hi(v_.z) * w_); o_.w = cvt_pk_bf16(bf_lo(v_.w) * w_, bf_hi(v_.w) * w_); \
            *(LAS u32x4*)(vb_ + 128 * row_ + 16 * (c16_ ^ (2 * sw128(row_)))) = o_; } } while (0)
#define SC_WRITE(dst_) do { _Pragma("unroll") for (int a = 0; a < 2; ++a) _Pragma("unroll") for (int b = 0; b < 2; ++b) { const int dk0 = 16 * (dkt0 + a) + 4 * g, dv = 64 * dvh + 16 * (dvt0 + b) + l15; \
            int w = __builtin_amdgcn_cvt_pk_fp8_f32(acc[a][b][0], acc[a][b][1], 0, false); w = __builtin_amdgcn_cvt_pk_fp8_f32(acc[a][b][2], acc[a][b][3], w, true); \
            *(int*)((unsigned char*)(dst_) + dv * 128 + dk0) = w; } } while (0)
#define CH(i_) (dir ? 31 - (i_) : (i_))
#define SC_STEP(step_, KN_, VN_) do { \
        bf16_t* st = ST + ((size_t)((cbase + CH(step_)) * 4 + h) * 2 + dir) * 16384; \
        SC_WRITE(st); \
        _Pragma("unroll") for (int a = 0; a < 2; ++a) _Pragma("unroll") for (int b = 0; b < 2; ++b) acc[a][b] = acc[a][b] * cd; \
        const LAS unsigned char* Kb = lds + ((step_) & 1) * 49152; const LAS unsigned char* Vb = Kb + 32768; \
        _Pragma("unroll") for (int ks = 0; ks < 4; ++ks) { \
            bf16x8 A[2], B[2]; const unsigned r0 = 32 * ks + 8 * g + q, r1 = r0 + 4; \
            _Pragma("unroll") for (int a = 0; a < 2; ++a) { const unsigned ch = 2 * (dkt0 + a) + (p >> 1); \
                A[a] = cat8(tr_read(Kb + off256(r0, ch) + 8 * (p & 1)), tr_read(Kb + off256(r1, ch) + 8 * (p & 1))); } \
            _Pragma("unroll") for (int b = 0; b < 2; ++b) { const unsigned blk = dvt0 + b; \
                B[b] = cat8(tr_read(Vb + 128 * r0 + 8 * (4 * (blk ^ sw128(r0)) + p)), tr_read(Vb + 128 * r1 + 8 * (4 * (blk ^ sw128(r1)) + p))); } \
            _Pragma("unroll") for (int a = 0; a < 2; ++a) _Pragma("unroll") for (int b = 0; b < 2; ++b) acc[a][b] = mfma16(A[a], B[b], acc[a][b]); } \
        if ((step_) + 1 < 32) SC_STORE(KN_, VN_, ((step_) + 1) & 1);            \
        if ((step_) + 3 < 32) SC_LOAD(KN_, VN_, CH((step_) + 3));               \
        LBAR(); } while (0)
    SC_LOAD(kA, vA, CH(0)); SC_LOAD(kB, vB, CH(1));
    SC_STORE(kA, vA, 0); LBAR();
    SC_LOAD(kA, vA, CH(2));
    for (int step = 0; step < 32; step += 2) {
        SC_STEP(step, kB, vB);
        SC_STEP(step + 1, kA, vA);
    }
    { bf16_t* fin = FIN + ((size_t)(vs * 4 + h) * 2 + dir) * 16384; SC_WRITE(fin); }
#undef SC_LOAD
#undef SC_STORE
#undef SC_WRITE
#undef SC_STEP
#undef CH
}

constexpr float NA_SHIFT = 14.f;
constexpr int NA_STRIPS = 640, NA_KR = 0, NA_VR = 9 * 8192, NA_RPB = 18 * 8192;
__device__ __forceinline__ int na_start(int r, int rows) { return min(max(r - 4, 0), rows - 8); }
__device__ __forceinline__ void na_strip(const Params& P, LAS unsigned char* lds, int strip, int hsel, int tid, int lane, int wave) {
    const bf16_t* PJ = (const bf16_t*)(P.ws + OFF_PROJ);
    const bf16_t* QA = PJ; const bf16_t* KA = PJ + SEC_STRIDE; const bf16_t* VA = PJ + 2 * SEC_STRIDE; const bf16_t* GA = PJ + 3 * SEC_STRIDE;
    bf16_t* MIX = (bf16_t*)(P.ws + OFF_MIX);
    int sq0, h, r0, rows;
    if (strip < 512) { sq0 = (strip >> 5) * 4096; h = (strip >> 2) & 7; r0 = (strip & 3) * 16; rows = 64; }
    else { const int v = strip - 512; sq0 = NP; h = v >> 4; r0 = (v & 15) * 16; rows = 256; }
    const int npairs = hsel < 0 ? 8 : 4; if (hsel > 0) r0 += 8;
    const int skey = tid >> 3, sc16 = tid & 7;
    const unsigned kdst = NA_KR + skey * 128 + 16 * (sc16 ^ (skey & 7)), vdst = NA_VR + skey * 128 + 16 * (sc16 ^ (((skey >> 1) & 3) << 1));
    const size_t ssrc = (size_t)skey * 512 + h * 64 + 8 * sc16;
    {
        const int lo = na_start(r0, rows);
        u32x4 kr[9], vr[9];
#pragma unroll
        for (int i = 0; i < 9; ++i) { const int row = min(lo + i, rows - 1); const size_t o = ((size_t)sq0 + (size_t)row * 64) * 512 + ssrc; kr[i] = *(const u32x4*)(KA + o); vr[i] = *(const u32x4*)(VA + o); }
#pragma unroll
        for (int i = 0; i < 9; ++i) { const int row = min(lo + i, rows - 1); const unsigned sl = (unsigned)(row % 9) * 8192u;
            if (lo + i < rows) { *(LAS u32x4*)(lds + sl + kdst) = kr[i]; *(LAS u32x4*)(lds + sl + vdst) = vr[i]; } }
        LAS float* rpbs = (LAS float*)(lds + NA_RPB);
        for (int i = tid; i < 465; i += 512) rpbs[i] = P.rpb[h * 465 + i] * LOG2E;
    }
    LBAR();
    const int rsel = wave >> 2, nb = wave & 3;
    const int g = lane >> 4, l15 = lane & 15, q4 = l15 >> 2, p = lane & 3;
    const int kstart = nb == 0 ? 0 : (nb == 1 ? 8 : (nb == 2 ? 24 : 32));
    const int qc = 16 * nb + l15, wsq = min(max(qc - 8, 0), 48);
    const LAS float* rp = (const LAS float*)(lds + NA_RPB);
    float msk[2][4]; int bofs[2][4];
#pragma unroll
    for (int kt = 0; kt < 2; ++kt)
#pragma unroll
        for (int i = 0; i < 4; ++i) { const int kc = kstart + 16 * kt + 4 * g + i; msk[kt][i] = ((kc >= wsq) && (kc < wsq + 16)) ? -NA_SHIFT : -INFINITY; bofs[kt][i] = min(max(kc - qc + 15, 0), 30); }
    bf16x8 qf[2];
    {   const size_t tq = (size_t)sq0 + (size_t)(r0 + rsel) * 64 + qc;
#pragma unroll
        for (int ks = 0; ks < 2; ++ks) qf[ks] = *(const bf16x8*)(QA + tq * 512 + h * 64 + 32 * ks + 8 * g); }
    for (int pi = 0; pi < npairs; ++pi) {
        const int r = r0 + 2 * pi, myr = r + rsel;
        const size_t tq = (size_t)sq0 + (size_t)myr * 64 + qc;
        const int lo = na_start(r, rows), lon = na_start(r + 2, rows);
        const int nr0 = lo + 9, nr1 = lo + 10;
        const bool need0 = (pi < npairs - 1) && (nr0 < lon + 9) && (nr0 < rows), need1 = (pi < npairs - 1) && (nr1 < lon + 9) && (nr1 < rows);
        u32x4 nk0, nv0, nk1, nv1;
        if (need0) { const size_t o = ((size_t)sq0 + (size_t)nr0 * 64) * 512 + ssrc; nk0 = *(const u32x4*)(KA + o); nv0 = *(const u32x4*)(VA + o); }
        if (need1) { const size_t o = ((size_t)sq0 + (size_t)nr1 * 64) * 512 + ssrc; nk1 = *(const u32x4*)(KA + o); nv1 = *(const u32x4*)(VA + o); }
        bf16x8 qn[2];
        if (pi < npairs - 1) {
#pragma unroll
            for (int ks = 0; ks < 2; ++ks) qn[ks] = *(const bf16x8*)(QA + (tq + 128) * 512 + h * 64 + 32 * ks + 8 * g); }
        u32x2 gv[4];
#pragma unroll
        for (int dt = 0; dt < 4; ++dt) gv[dt] = *(const u32x2*)(GA + tq * 512 + h * 64 + 16 * dt + 4 * g);
        const int start = na_start(myr, rows);
        f32x4 sc[8][2];
#pragma unroll
        for (int j = 0; j < 8; ++j) { const LAS float* rpj = rp + (start + j - myr + 7) * 31;
#pragma unroll
            for (int kt = 0; kt < 2; ++kt)
#pragma unroll
                for (int i = 0; i < 4; ++i) sc[j][kt][i] = rpj[bofs[kt][i]] + msk[kt][i]; }
#pragma unroll
        for (int j = 0; j < 8; ++j) { const LAS unsigned char* kt_ = lds + NA_KR + (unsigned)((start + j) % 9) * 8192u;
#pragma unroll
            for (int kt = 0; kt < 2; ++kt) { const unsigned key = kstart + 16 * kt + l15; const LAS unsigned char* kp = kt_ + key * 128;
                f32x4 a = sc[j][kt];
                a = mfma16(*(const LAS bf16x8*)(kp + 16 * ((unsigned)g ^ (key & 7))), qf[0], a);
                a = mfma16(*(const LAS bf16x8*)(kp + 16 * ((unsigned)(4 + g) ^ (key & 7))), qf[1], a);
                sc[j][kt] = a; } }
#pragma unroll
        for (int j = 0; j < 8; ++j)
#pragma unroll
            for (int kt = 0; kt < 2; ++kt)
#pragma unroll
                for (int i = 0; i < 4; ++i) sc[j][kt][i] = __builtin_amdgcn_exp2f(sc[j][kt][i]);
        f32x4 o[4], osum = (f32x4){0.f, 0.f, 0.f, 0.f};
#pragma unroll
        for (int dt = 0; dt < 4; ++dt) o[dt] = (f32x4){0.f, 0.f, 0.f, 0.f};
        const bf16x8 ones8 = (bf16x8){0x3f80, 0x3f80, 0x3f80, 0x3f80, 0x3f80, 0x3f80, 0x3f80, 0x3f80};
#pragma unroll
        for (int j = 0; j < 8; ++j) {
            u32x4 pw; pw.x = cvt_pk_bf16(sc[j][0][0], sc[j][0][1]); pw.y = cvt_pk_bf16(sc[j][0][2], sc[j][0][3]); pw.z = cvt_pk_bf16(sc[j][1][0], sc[j][1][1]); pw.w = cvt_pk_bf16(sc[j][1][2], sc[j][1][3]);
            const bf16x8 pb = __builtin_bit_cast(bf16x8, pw);
            const LAS unsigned char* vt = lds + NA_VR + (unsigned)((start + j) % 9) * 8192u;
            const unsigned k0 = kstart + 4 * g + q4, k1 = k0 + 16;
            const unsigned x0 = 4 * ((k0 >> 1) & 3), x1 = 4 * ((k1 >> 1) & 3);
#pragma unroll
            for (int dt = 0; dt < 4; ++dt) {
                const bf16x8 va = cat8(tr_read(vt + k0 * 128 + 8 * ((unsigned)(4 * dt + p) ^ x0)), tr_read(vt + k1 * 128 + 8 * ((unsigned)(4 * dt + p) ^ x1)));
                o[dt] = mfma16(va, pb, o[dt]); }
            osum = mfma16(ones8, pb, osum);
        }
        const float inv = __builtin_amdgcn_rcpf(osum[0]);
#pragma unroll
        for (int dt = 0; dt < 4; ++dt) {
            u32x2 w; w.x = cvt_pk_bf16(o[dt][0] * inv * bf_lo(gv[dt].x), o[dt][1] * inv * bf_hi(gv[dt].x)); w.y = cvt_pk_bf16(o[dt][2] * inv * bf_lo(gv[dt].y), o[dt][3] * inv * bf_hi(gv[dt].y));
            *(u32x2*)(MIX + tq * DM + h * 64 + 16 * dt + 4 * g) = w; }
        LBAR();
        if (need0) { const unsigned sl = (unsigned)(nr0 % 9) * 8192u; *(LAS u32x4*)(lds + sl + kdst) = nk0; *(LAS u32x4*)(lds + sl + vdst) = nv0; }
        if (need1) { const unsigned sl = (unsigned)(nr1 % 9) * 8192u; *(LAS u32x4*)(lds + sl + kdst) = nk1; *(LAS u32x4*)(lds + sl + vdst) = nv1; }
        if (pi < npairs - 1) { qf[0] = qn[0]; qf[1] = qn[1]; }
        LBAR();
    }
}

__device__ __forceinline__ void ret_phase(const Params& P, LAS unsigned char* lds, int tid, int lane, int wave, int bid, int G) {
    const bf16_t* PJ = (const bf16_t*)(P.ws + OFF_PROJ);
    const bf16_t* QR = PJ + 4 * SEC_STRIDE; const bf16_t* KR = PJ + 5 * SEC_STRIDE; const bf16_t* VR = PJ + 6 * SEC_STRIDE; const bf16_t* GR = PJ + 7 * SEC_STRIDE;
    const bf16_t* ST = (const bf16_t*)(P.ws + OFF_ST); const bf16_t* FIN = (const bf16_t*)(P.ws + OFF_FIN); bf16_t* MIX = (bf16_t*)(P.ws + OFF_MIX);
    LAS unsigned char* Qt = lds; LAS unsigned char* Kt = lds + 32768; LAS unsigned char* Vt = lds + 65536; LAS unsigned char* Pt = lds + 98304;
    int g = lane >> 4, l15 = lane & 15, q4 = l15 >> 2, p = lane & 3, w16 = wave * 16;
#define OPQ_ALL() do { asm volatile("" : "+v"(g), "+v"(l15), "+v"(q4), "+v"(p)); } while (0)
    int u = bid; if (u >= RET_UNITS) return;
    u32x4 rq[4], rk[4], rv[4];
#define RT_LOAD(u_) do { const size_t tokc_ = (size_t)((u_) >> 2) * 128; const int h_ = (u_) & 3; \
        _Pragma("unroll") for (int i = 0; i < 4; ++i) { const int idx = tid + 512 * i; const size_t src = (tokc_ + (idx >> 4)) * 512 + h_ * 128 + 8 * (idx & 15); \
            rq[i] = *(const u32x4*)(QR + src); rk[i] = *(const u32x4*)(KR + src); rv[i] = *(const u32x4*)(VR + src); } } while (0)
    RT_LOAD(u);
    for (; u < RET_UNITS; u += G) {
        const int gc = u >> 2, h = u & 3; const size_t tokc = (size_t)gc * 128;
        const float lgf2 = -__expf(P.dec_f[h]) * LOG2E, lgb2 = -__expf(P.dec_b[h]) * LOG2E;
#pragma unroll
        for (int i = 0; i < 4; ++i) { const int idx = tid + 512 * i; const unsigned d = off256(idx >> 4, idx & 15);
            *(LAS u32x4*)(Qt + d) = rq[i]; *(LAS u32x4*)(Kt + d) = rk[i]; *(LAS u32x4*)(Vt + d) = rv[i]; }
        LBAR();
        const bf16_t* Sf = ST + ((size_t)(gc * 4 + h) * 2 + 0) * 16384; const bf16_t* Sb = Sf + 16384;
        u32x4 rsf[2], rsb[2];
#pragma unroll
        for (int j = 0; j < 2; ++j) { const int idx = tid + 512 * j; rsf[j] = *(const u32x4*)((const unsigned char*)Sf + 16 * idx); rsb[j] = *(const u32x4*)((const unsigned char*)Sb + 16 * idx); }
        OPQ_ALL();
        bf16x8 qf[4];
#pragma unroll
        for (int ks = 0; ks < 4; ++ks) qf[ks] = *(const LAS bf16x8*)(Qt + off256(w16 + l15, 4 * ks + g));
        {
            const int n = w16 + l15;
            f32x4 sa[8];
#pragma unroll
            for (int mt = 0; mt < 8; ++mt) {
                f32x4 a = (f32x4){0.f, 0.f, 0.f, 0.f};
#pragma unroll
                for (int ks = 0; ks < 4; ++ks) a = mfma16(*(const LAS bf16x8*)(Kt + off256(16 * mt + l15, 4 * ks + g)), qf[ks], a);
                sa[mt] = a; }
#pragma unroll
            for (int mt = 0; mt < 8; ++mt) {
                const f32x4 a = sa[mt];
                float e[4];
#pragma unroll
                for (int i = 0; i < 4; ++i) { const int m = 16 * mt + 4 * g + i, df = n - m; const float f = __builtin_amdgcn_exp2f(df >= 0 ? lgf2 * (float)df : lgb2 * (float)(-df)); e[i] = a[i] * f; }
                u32x2 w; w.x = cvt_pk_bf16(e[0], e[1]); w.y = cvt_pk_bf16(e[2], e[3]);
                *(LAS u32x2*)(Pt + off256(n, 2 * mt + (g >> 1)) + 8 * (g & 1)) = w;
            }
        }
        LBAR();
        u32x4 sfr[4], sbr[4];
#pragma unroll
        for (int j = 0; j < 2; ++j) { sfr[2 * j] = fp8x8_to_bf16x8(rsf[j].x, rsf[j].y); sfr[2 * j + 1] = fp8x8_to_bf16x8(rsf[j].z, rsf[j].w);
            sbr[2 * j] = fp8x8_to_bf16x8(rsb[j].x, rsb[j].y); sbr[2 * j + 1] = fp8x8_to_bf16x8(rsb[j].z, rsb[j].w); }
#define ST_FMA(dst_, f_, w_) do { u32x4 s_ = dst_; \
            s_.x = cvt_pk_bf16(bf_lo(s_.x) + (w_) * bf_lo((f_).x), bf_hi(s_.x) + (w_) * bf_hi((f_).x)); s_.y = cvt_pk_bf16(bf_lo(s_.y) + (w_) * bf_lo((f_).y), bf_hi(s_.y) + (w_) * bf_hi((f_).y)); \
            s_.z = cvt_pk_bf16(bf_lo(s_.z) + (w_) * bf_lo((f_).z), bf_hi(s_.z) + (w_) * bf_hi((f_).z)); s_.w = cvt_pk_bf16(bf_lo(s_.w) + (w_) * bf_lo((f_).w), bf_hi(s_.w) + (w_) * bf_hi((f_).w)); dst_ = s_; } while (0)
        if (gc >= 512) {
            const int k = (gc - 512) >> 5, j = gc & 31;
            const float cf = exp2f(lgf2 * 128.f * (float)j), cb = exp2f(lgb2 * 128.f * (float)(31 - j)), df32 = exp2f(lgf2 * 4096.f), db32 = exp2f(lgb2 * 4096.f);
            float wgt = cf;
            for (int i2 = k - 1; i2 >= 0; --i2) { const unsigned char* F = (const unsigned char*)(FIN + ((size_t)((16 + i2) * 4 + h) * 2 + 0) * 16384);
#pragma unroll
                for (int jj = 0; jj < 2; ++jj) { const u32x4 rf = *(const u32x4*)(F + 16 * (tid + 512 * jj)); const u32x4 f0 = fp8x8_to_bf16x8(rf.x, rf.y), f1 = fp8x8_to_bf16x8(rf.z, rf.w);
                    ST_FMA(sfr[2 * jj], f0, wgt); ST_FMA(sfr[2 * jj + 1], f1, wgt); }
                wgt *= df32; }
            wgt = cb;
            for (int i2 = k + 1; i2 < 4; ++i2) { const unsigned char* F = (const unsigned char*)(FIN + ((size_t)((16 + i2) * 4 + h) * 2 + 1) * 16384);
#pragma unroll
                for (int jj = 0; jj < 2; ++jj) { const u32x4 rf = *(const u32x4*)(F + 16 * (tid + 512 * jj)); const u32x4 f0 = fp8x8_to_bf16x8(rf.x, rf.y), f1 = fp8x8_to_bf16x8(rf.z, rf.w);
                    ST_FMA(sbr[2 * jj], f0, wgt); ST_FMA(sbr[2 * jj + 1], f1, wgt); }
                wgt *= db32; }
        }
#undef ST_FMA
#pragma unroll
        for (int j = 0; j < 2; ++j) { const int idx = tid + 512 * j; const unsigned row = idx >> 3, c8 = idx & 7;
            *(LAS u32x4*)(Qt + off256(row, 2 * c8)) = sfr[2 * j]; *(LAS u32x4*)(Qt + off256(row, 2 * c8 + 1)) = sfr[2 * j + 1];
            *(LAS u32x4*)(Kt + off256(row, 2 * c8)) = sbr[2 * j]; *(LAS u32x4*)(Kt + off256(row, 2 * c8 + 1)) = sbr[2 * j + 1]; }
        if (u + G < RET_UNITS) RT_LOAD(u + G);
        LBAR();
        OPQ_ALL();
        f32x4 o[8];
#pragma unroll
        for (int t = 0; t < 8; ++t) o[t] = (f32x4){0.f, 0.f, 0.f, 0.f};
        u32x4 grv[4];
#pragma unroll
        for (int it = 0; it < 4; ++it) grv[it] = *(const u32x4*)(GR + (tokc + w16 + 4 * it + g) * 512 + h * 128 + 8 * l15);
#pragma unroll
        for (int t = 0; t < 8; ++t)
#pragma unroll
            for (int ks = 0; ks < 4; ++ks) { o[t] = mfma16(qf[ks], *(const LAS bf16x8*)(Qt + off256(16 * t + l15, 4 * ks + g)), o[t]); }
        float wb[4];
#pragma unroll
        for (int i = 0; i < 4; ++i) { const float pos = (float)(w16 + 4 * g + i); const float wf = exp2f(lgf2 * (pos + 1.f)); wb[i] = exp2f(lgb2 * (128.f - pos)); const float rt = wf / wb[i];
#pragma unroll
            for (int t = 0; t < 8; ++t) o[t][i] *= rt; }
#pragma unroll
        for (int t = 0; t < 8; ++t)
#pragma unroll
            for (int ks = 0; ks < 4; ++ks) { o[t] = mfma16(qf[ks], *(const LAS bf16x8*)(Kt + off256(16 * t + l15, 4 * ks + g)), o[t]); }
#pragma unroll
        for (int i = 0; i < 4; ++i)
#pragma unroll
            for (int t = 0; t < 8; ++t) o[t][i] *= wb[i];
        OPQ_ALL();
#pragma unroll
        for (int ks = 0; ks < 4; ++ks) {
            const bf16x8 pa = *(const LAS bf16x8*)(Pt + off256(w16 + l15, 4 * ks + g));
            const unsigned r0 = 32 * ks + 8 * g + q4, r1 = r0 + 4;
#pragma unroll
            for (int t = 0; t < 8; ++t) { const unsigned ch = 2 * t + (p >> 1);
                const bf16x8 vb = cat8(tr_read(Vt + off256(r0, ch) + 8 * (p & 1)), tr_read(Vt + off256(r1, ch) + 8 * (p & 1)));
                o[t] = mfma16(pa, vb, o[t]); }
        }
        OPQ_ALL();
        float rs[4];
#pragma unroll
        for (int i = 0; i < 4; ++i) { float ss = 0.f;
#pragma unroll
            for (int t = 0; t < 8; ++t) ss += o[t][i] * o[t][i];
            ss += __shfl_xor(ss, 1); ss += __shfl_xor(ss, 2); ss += __shfl_xor(ss, 4); ss += __shfl_xor(ss, 8);
            rs[i] = rsqrtf(ss * (1.f / 128.f) + EPS); }
        LBAR();
#pragma unroll
        for (int t = 0; t < 8; ++t) { const int dv = 16 * t + l15; const float gn = P.rgain[h * 128 + dv];
#pragma unroll
            for (int i = 0; i < 4; ++i) { const int n = w16 + 4 * g + i; const unsigned wv = cvt_pk_bf16(o[t][i] * rs[i] * gn, 0.f);
                *(LAS unsigned short*)(Pt + off256(n, dv >> 3) + 2 * (dv & 7)) = (unsigned short)(wv & 0xffffu); } }
        LBAR();
#pragma unroll
        for (int it = 0; it < 4; ++it) { const int row = w16 + 4 * it + g, ch = l15;
            const u32x4 ov = *(const LAS u32x4*)(Pt + off256(row, ch));
            const u32x4 gv = grv[it];
            u32x4 w; w.x = cvt_pk_bf16(bf_lo(ov.x) * bf_lo(gv.x), bf_hi(ov.x) * bf_hi(gv.x)); w.y = cvt_pk_bf16(bf_lo(ov.y) * bf_lo(gv.y), bf_hi(ov.y) * bf_hi(gv.y));
            w.z = cvt_pk_bf16(bf_lo(ov.z) * bf_lo(gv.z), bf_hi(ov.z) * bf_hi(gv.z)); w.w = cvt_pk_bf16(bf_lo(ov.w) * bf_lo(gv.w), bf_hi(ov.w) * bf_hi(gv.w));
            *(u32x4*)(MIX + (tokc + row) * DM + 512 + h * 128 + 8 * ch) = w; }
        LBAR();
    }
#undef RT_LOAD
#undef OPQ_ALL
}

#define XB_TMO      128
#define XB_XCNT(j)  (256  + 64 * (j))
#define XB_XSUB(j)  (1280 + 64 * (j))
#define XB_XGEN(j)  (2304 + 64 * (j))
#define XB_TOP      3328
#define XB_TOPGEN   3392
#define XCD_BAR_WORDS 3456
#define XB_SPIN_CAP (1u << 18)

__device__ __forceinline__ unsigned xb_ld(unsigned* p)              { return __hip_atomic_load(p, __ATOMIC_RELAXED, __HIP_MEMORY_SCOPE_AGENT); }
__device__ __forceinline__ unsigned xb_add(unsigned* p, unsigned v) { return __hip_atomic_fetch_add(p, v, __ATOMIC_RELAXED, __HIP_MEMORY_SCOPE_AGENT); }
__device__ __forceinline__ unsigned xb_xcc_id() { return (unsigned)__builtin_amdgcn_s_getreg((3 << 11) | 20) & 0xFu; }
#define XB_SPIN(cond, bar) do { unsigned _sp = 0; while (cond) { __builtin_amdgcn_s_sleep(1); \
    if ((++_sp & 255u) == 0u) { if (xb_ld(&(bar)[XB_TMO])) break; if (_sp > XB_SPIN_CAP) { atomicAdd(&(bar)[XB_TMO], 1u); break; } } } } while (0)

struct XcdBarrier {
    unsigned* bar; unsigned x;
    volatile LAS unsigned* st;
};

__device__ __forceinline__ XcdBarrier xcd_barrier_post(unsigned* bar, volatile LAS unsigned* st) {
    XcdBarrier b; b.bar = bar; b.x = xb_xcc_id(); b.st = st;
    if (threadIdx.x == 0) (void)xb_add(&bar[XB_XCNT(b.x)], 1u);
    return b;
}
__device__ __forceinline__ void xcd_barrier_complete(unsigned* bar, unsigned x, unsigned& nloc, unsigned& nx) {
    const unsigned G = gridDim.x * gridDim.y * gridDim.z;
    unsigned sum, cnt, mine, sp = 0u;
    for (;;) {
        sum = 0u; cnt = 0u; mine = 0u;
#pragma unroll
        for (unsigned j = 0; j < 16; ++j) { const unsigned c = xb_ld(&bar[XB_XCNT(j)]); sum += c; cnt += (c > 0u) ? 1u : 0u; mine = (j == x) ? c : mine; }
        if (sum == G) break;
        __builtin_amdgcn_s_sleep(1);
        if ((++sp & 255u) == 0u) { if (xb_ld(&bar[XB_TMO])) break; if (sp > XB_SPIN_CAP) { atomicAdd(&bar[XB_TMO], 1u); break; } }
    }
    nloc = mine > 0u ? mine : 1u; nx = cnt > 0u ? cnt : 1u;
}

__device__ __forceinline__ void xcd_barrier(const XcdBarrier& b) {
    asm volatile("s_waitcnt vmcnt(0)" ::: "memory");
    __syncthreads();
    if (threadIdx.x == 0) {
        unsigned* bar = b.bar;
        __builtin_amdgcn_s_waitcnt(0);
        unsigned nloc = b.st[0], nx = b.st[1];
        if (nloc == 0u) { xcd_barrier_complete(bar, b.x, nloc, nx); b.st[0] = nloc; b.st[1] = nx; }
        const unsigned old = xb_add(&bar[XB_XSUB(b.x)], 1u);
        const unsigned gen = old / nloc;
        if (old + 1u == (gen + 1u) * nloc) {
            __builtin_amdgcn_fence(__ATOMIC_RELEASE, "agent");
            asm volatile("s_waitcnt vmcnt(0)" ::: "memory");
            const unsigned og = xb_add(&bar[XB_TOP], 1u);
            const unsigned tg = og / nx;
            if (og + 1u == (tg + 1u) * nx) xb_add(&bar[XB_TOPGEN], 1u);
            else XB_SPIN(xb_ld(&bar[XB_TOPGEN]) == tg, bar);
            __builtin_amdgcn_fence(__ATOMIC_ACQUIRE, "agent");
            xb_add(&bar[XB_XGEN(b.x)], 1u);
            asm volatile("s_waitcnt vmcnt(0)" ::: "memory");
        } else {
            XB_SPIN(xb_ld(&bar[XB_XGEN(b.x)]) == gen, bar);
            __builtin_amdgcn_fence(__ATOMIC_ACQUIRE, "agent");
            asm volatile("s_waitcnt vmcnt(0)" ::: "memory");
        }
    }
    __syncthreads();
}

#ifndef MK_MULTI
#define MK_MULTI 0
#endif
constexpr int N_PHASES = 6;
constexpr int CW_BAR = 4096;
#ifndef PROBE_PHASE
#define PROBE_PHASE (-1)
#endif
#define REPS(k) for (int rep_ = 0; rep_ < ((PROBE_PHASE) == (k) ? 2 : 1); ++rep_)
__global__ void __launch_bounds__(512, 2) mk_fwd(Params P, int ph_lo, int ph_hi) {
    extern __shared__ __attribute__((aligned(16))) unsigned char lds_raw[];
    LAS unsigned char* lds = (LAS unsigned char*)lds_raw;
    const int tid = threadIdx.x, lane = tid & 63, wave = __builtin_amdgcn_readfirstlane(tid >> 6), bid = blockIdx.x, G = gridDim.x;
    volatile LAS unsigned* bst = (volatile LAS unsigned*)(lds + LDS_MISC + 32);
    if (tid < 2) bst[tid] = 0u;
    __syncthreads();
    XcdBarrier xbar = xcd_barrier_post((unsigned*)(P.ws + OFF_CTL) + CW_BAR, bst);
#define IN(k) (ph_lo <= (k) && (k) < ph_hi)
#define SEAM(k) do { if (IN(k) && IN((k) + 1)) xcd_barrier(xbar); } while (0)
    if (IN(0)) REPS(0) phase0a(P, lds, tid, lane, wave, bid, G);
    SEAM(0);
    if (IN(1)) REPS(1) phase0b(P, lane, wave, bid, G);
    SEAM(1);
    if (IN(2)) REPS(2) {
        pg8::Gemm gm{(const bf16_t*)(P.ws + OFF_H), (const bf16_t*)(P.ws + OFF_WTIN), NTOK, 4096, 1024}; pg8::StaticOrder S; S.init(NTOK, 4096, G, bid);
        EpiIn E{(bf16_t*)(P.ws + OFF_PROJ), P.qg, P.kg, (const float*)(P.ws + OFF_ROPE), (const float*)(P.ws + OFF_ROPE) + 16384 * 64};
        pg8::gemm_phase<EpiIn, pg8::StaticOrder, true, true>(lds, gm, S, E);
    }
    SEAM(2);
    if (IN(3)) REPS(3) {
        unsigned* ctr = (unsigned*)(P.ws + OFF_CTL) + 64 * rep_;
        LAS unsigned* misc = (LAS unsigned*)(lds + LDS_MISC);
        for (;;) {
            __syncthreads();
            if (tid == 0) misc[0] = atomicAdd(ctr, 1u);
            __syncthreads();
            const int unit = (int)misc[0];
            if (unit >= SCAN_UNITS + 512 + 256) break;
            if (unit < SCAN_UNITS) scan_unit(P, lds, unit >> 4, (unit >> 2) & 3, (unit >> 1) & 1, unit & 1, tid, lane, wave);
            else { const int j = unit - SCAN_UNITS - 512; const bool full = j < 0; na_strip(P, lds, full ? unit - SCAN_UNITS : 512 + (j >> 1), full ? -1 : (j & 1), tid, lane, wave); }
        }
    }
    SEAM(3);
    if (IN(4)) REPS(4) ret_phase(P, lds, tid, lane, wave, bid, G);
    SEAM(4);
    if (IN(5)) REPS(5) {
        pg8::Gemm gm{(const bf16_t*)(P.ws + OFF_MIX), (const bf16_t*)(P.ws + OFF_WTOUT), NTOK, 1024, 1024}; pg8::StaticOrder S; S.init(NTOK, 1024, G, bid);
        EpiOut E{P.xp, P.xs, (const float*)(P.ws + OFF_MOD), P.out};
        pg8::gemm_phase<EpiOut, pg8::StaticOrder, true, true>(lds, gm, S, E);
    }
#undef IN
#undef SEAM
}

extern "C" void kernel_launch(void* const* d_in, const int* in_sizes, int n_in, void* d_out, int out_size, void* d_ws, size_t ws_size, hipStream_t stream) {
    static int grid = 0;
    if (grid == 0) {
        if (n_in != 15 || ws_size < WS_NEED) { fprintf(stderr, "kernel_launch: unexpected n_in %d / ws_size %zu\n", n_in, ws_size); grid = -1; return; }
        int dev = 0, cus = 0, per_cu = 0;
        hipGetDevice(&dev); hipDeviceGetAttribute(&cus, hipDeviceAttributeMultiprocessorCount, dev);
        if (hipFuncSetAttribute((const void*)mk_fwd, hipFuncAttributeMaxDynamicSharedMemorySize, LDS_BYTES) != hipSuccess) { fprintf(stderr, "kernel_launch: hipFuncSetAttribute failed\n"); grid = -1; return; }
        if (hipOccupancyMaxActiveBlocksPerMultiprocessor(&per_cu, (const void*)mk_fwd, 512, LDS_BYTES) != hipSuccess || per_cu < 1) { fprintf(stderr, "kernel_launch: occupancy query gave %d\n", per_cu); grid = -1; (void)hipGetLastError(); return; }
        grid = cus * per_cu;
    }
    if (grid < 0) return;
    (void)hipMemsetAsync((char*)d_ws + OFF_CTL, 0, 32768, stream);
    Params p{};
    p.xp = (const float*)d_in[0]; p.xs = (const float*)d_in[1]; p.cp = (const float*)d_in[2]; p.csm = (const float*)d_in[3];
    p.norm_gain = (const float*)d_in[4]; p.w_ada = (const float*)d_in[5]; p.b_ada = (const float*)d_in[6]; p.w_in = (const float*)d_in[7];
    p.qg = (const float*)d_in[8]; p.kg = (const float*)d_in[9]; p.rpb = (const float*)d_in[10]; p.dec_f = (const float*)d_in[11]; p.dec_b = (const float*)d_in[12];
    p.rgain = (const float*)d_in[13]; p.w_out = (const float*)d_in[14];
    p.out = (float*)d_out; p.ws = (unsigned char*)d_ws;
#if MK_MULTI
    for (int k = 0; k < N_PHASES; ++k) { int lo = k, hi = k + 1; void* args[] = {&p, &lo, &hi};
        hipError_t e = hipLaunchCooperativeKernel((const void*)mk_fwd, dim3(grid), dim3(512), args, LDS_BYTES, stream);
        if (e != hipSuccess) { fprintf(stderr, "launch %d failed: %s\n", k, hipGetErrorString(e)); break; } }
#else
    int lo = 0, hi = N_PHASES; void* args[] = {&p, &lo, &hi};
    hipError_t e = hipLaunchCooperativeKernel((const void*)mk_fwd, dim3(grid), dim3(512), args, LDS_BYTES, stream);
    if (e != hipSuccess) fprintf(stderr, "cooperative launch failed: %s (grid %d)\n", hipGetErrorString(e), grid);
#endif
}
```
